# Optimizing an MI355X kernel written in HIP

```python
import jax, jax.numpy as jnp
from jax import lax
import numpy as np

D_MODEL = 1024
BATCH = 2
SEQ = 8192
DEPTH = 2

N_A_LAYERS = DEPTH // 2
N_B_LAYERS = DEPTH - N_A_LAYERS
FOX_HEADS = 16
FOX_HEAD_DIM = D_MODEL // FOX_HEADS
FOX_WIDTH = FOX_HEADS * FOX_HEAD_DIM
FOX_IN_COLS = 3 * FOX_WIDTH + FOX_HEADS
MLA_HEADS = 8
QK_NOPE_DIM = 128
QK_ROPE_DIM = 64
V_HEAD_DIM = 128
Q_LORA_RANK = 384
KV_LORA_RANK = 256
ROPE_BASE = 10000.0
D_FF = 4 * D_MODEL
Q_BLOCK = 128
EPS = 1e-6

kernel_name = "yoco_fox_mla_hybrid"


def rms_norm(x, g):
    xf = x.astype(jnp.float32)
    y = xf * lax.rsqrt(jnp.mean(xf * xf, axis=-1, keepdims=True) + EPS)
    return (y * g.astype(jnp.float32)).astype(x.dtype)


def sq_relu_mlp(h, w_up, w_down):
    return jnp.square(jax.nn.relu(h @ w_up)) @ w_down


def rope_tables(seq_len, dim):
    inv = 1.0 / (ROPE_BASE ** (jnp.arange(0, dim, 2, dtype=jnp.float32) / dim))
    ang = jnp.arange(seq_len, dtype=jnp.float32)[:, None] * inv[None, :]
    return jnp.cos(ang), jnp.sin(ang)


def apply_rope(t, cos, sin):
    cos = cos.astype(t.dtype)
    sin = sin.astype(t.dtype)
    half = t.shape[-1] // 2
    t1, t2 = t[..., :half], t[..., half:]
    return jnp.concatenate([t1 * cos - t2 * sin, t2 * cos + t1 * sin], axis=-1)


def causal_block_attention(logits_fn, q_parts, v):
    B, S = v.shape[0], v.shape[1]
    nb = S // Q_BLOCK
    blocks = tuple(jnp.moveaxis(t.reshape((B, nb, Q_BLOCK) + t.shape[2:]), 1, 0) for t in q_parts)
    kpos = jnp.arange(S)

    def one_block(args):
        i, qb = args
        logits = logits_fn(qb)
        qpos = i * Q_BLOCK + jnp.arange(Q_BLOCK)
        logits = jnp.where(kpos[None, :] <= qpos[:, None], logits, -jnp.inf)
        p = jax.nn.softmax(logits, axis=-1).astype(v.dtype)
        return jnp.einsum('bhqk,bkhd->bqhd', p, v)

    out = lax.map(one_block, (jnp.arange(nb), blocks))
    return jnp.moveaxis(out, 0, 1).reshape((B, S) + out.shape[3:])


def fox_mixer(h, w_in, b_f, w_out):
    B, S, _ = h.shape
    proj = h @ w_in
    q = proj[..., :FOX_WIDTH].reshape(B, S, FOX_HEADS, FOX_HEAD_DIM)
    k = proj[..., FOX_WIDTH:2 * FOX_WIDTH].reshape(B, S, FOX_HEADS, FOX_HEAD_DIM)
    v = proj[..., 2 * FOX_WIDTH:3 * FOX_WIDTH].reshape(B, S, FOX_HEADS, FOX_HEAD_DIM)
    f_logit = proj[..., 3 * FOX_WIDTH:].astype(jnp.float32) + b_f.astype(jnp.float32)
    cum = jnp.cumsum(jax.nn.log_sigmoid(f_logit), axis=1)
    c_keys = jnp.transpose(cum, (0, 2, 1))
    scale = FOX_HEAD_DIM ** -0.5

    def logits_fn(qb):
        q_blk, c_blk = qb
        s = jnp.einsum('bqhd,bkhd->bhqk', q_blk, k, preferred_element_type=jnp.float32) * scale
        return s + jnp.transpose(c_blk, (0, 2, 1))[..., None] - c_keys[:, :, None, :]

    ctx = causal_block_attention(logits_fn, (q, cum), v)
    return ctx.reshape(B, S, FOX_WIDTH) @ w_out


def mla_shared_kv(stream, kv_norm_g, w_kv_a, kv_a_norm_g, w_kv_b, cos, sin):
    B, S, _ = stream.shape
    src = rms_norm(stream, kv_norm_g)
    kv_a = src @ w_kv_a
    c_kv = rms_norm(kv_a[..., :KV_LORA_RANK], kv_a_norm_g)
    k_rope = apply_rope(kv_a[..., KV_LORA_RANK:], cos, sin)
    kv_b = (c_kv @ w_kv_b).reshape(B, S, MLA_HEADS, QK_NOPE_DIM + V_HEAD_DIM)
    k_nope = kv_b[..., :QK_NOPE_DIM]
    v = kv_b[..., QK_NOPE_DIM:]
    return k_nope, k_rope, v


def mla_mixer(h, w_q_a, q_a_norm_g, w_q_b, w_out, k_nope, k_rope, v, cos, sin):
    B, S, _ = h.shape
    c_q = rms_norm(h @ w_q_a, q_a_norm_g)
    q = (c_q @ w_q_b).reshape(B, S, MLA_HEADS, QK_NOPE_DIM + QK_ROPE_DIM)
    q_nope = q[..., :QK_NOPE_DIM]
    q_rope = apply_rope(q[..., QK_NOPE_DIM:], cos[:, None, :], sin[:, None, :])
    scale = (QK_NOPE_DIM + QK_ROPE_DIM) ** -0.5

    def logits_fn(qb):
        qn, qr = qb
        s = jnp.einsum('bqhd,bkhd->bhqk', qn, k_nope, preferred_element_type=jnp.float32)
        s = s + jnp.einsum('bqhr,bkr->bhqk', qr, k_rope, preferred_element_type=jnp.float32)
        return s * scale

    ctx = causal_block_attention(logits_fn, (q_nope, q_rope), v)
    return ctx.reshape(B, S, MLA_HEADS * V_HEAD_DIM) @ w_out


def setup_inputs(seed: int = 0) -> dict:
    key = jax.random.key(seed)
    ks = jax.random.split(key, 24)

    def w(k, shape, fan_in):
        return jax.random.normal(k, shape, jnp.float32) * (fan_in ** -0.5)

    def gain(k, shape):
        return 1.0 + 0.02 * jax.random.normal(k, shape, jnp.float32)

    return {
        "x": jax.random.normal(ks[0], (BATCH, SEQ, D_MODEL), jnp.float32),
        "norm_mix_g": gain(ks[1], (DEPTH, D_MODEL)),
        "norm_ffn_g": gain(ks[2], (DEPTH, D_MODEL)),
        "fox_w_in": w(ks[3], (N_A_LAYERS, D_MODEL, FOX_IN_COLS), D_MODEL),
        "fox_b_f": 1.0 + 0.1 * jax.random.normal(ks[4], (N_A_LAYERS, FOX_HEADS), jnp.float32),
        "fox_w_out": w(ks[5], (N_A_LAYERS, FOX_WIDTH, D_MODEL), FOX_WIDTH),
        "kv_norm_g": gain(ks[6], (D_MODEL,)),
        "mla_w_kv_a": w(ks[7], (D_MODEL, KV_LORA_RANK + QK_ROPE_DIM), D_MODEL),
        "mla_kv_a_norm_g": gain(ks[8], (KV_LORA_RANK,)),
        "mla_w_kv_b": w(ks[9], (KV_LORA_RANK, MLA_HEADS * (QK_NOPE_DIM + V_HEAD_DIM)), KV_LORA_RANK),
        "mla_w_q_a": w(ks[10], (N_B_LAYERS, D_MODEL, Q_LORA_RANK), D_MODEL),
        "mla_q_a_norm_g": gain(ks[11], (N_B_LAYERS, Q_LORA_RANK)),
        "mla_w_q_b": w(ks[12], (N_B_LAYERS, Q_LORA_RANK, MLA_HEADS * (QK_NOPE_DIM + QK_ROPE_DIM)), Q_LORA_RANK),
        "mla_w_out": w(ks[13], (N_B_LAYERS, MLA_HEADS * V_HEAD_DIM, D_MODEL), MLA_HEADS * V_HEAD_DIM),
        "ffn_w_up": w(ks[14], (DEPTH, D_MODEL, D_FF), D_MODEL),
        "ffn_w_down": w(ks[15], (DEPTH, D_FF, D_MODEL), D_FF),
        "final_norm_g": gain(ks[16], (D_MODEL,)),
    }


def reference(x, norm_mix_g, norm_ffn_g, fox_w_in, fox_b_f, fox_w_out, kv_norm_g,
              mla_w_kv_a, mla_kv_a_norm_g, mla_w_kv_b, mla_w_q_a, mla_q_a_norm_g,
              mla_w_q_b, mla_w_out, ffn_w_up, ffn_w_down, final_norm_g):
    S = x.shape[1]
    cos, sin = rope_tables(S, QK_ROPE_DIM)
    k_nope = k_rope = v_shared = None
    for layer in range(DEPTH):
        h = rms_norm(x, norm_mix_g[layer])
        if layer < N_A_LAYERS:
            x = x + fox_mixer(h, fox_w_in[layer], fox_b_f[layer], fox_w_out[layer])
        else:
            b = layer - N_A_LAYERS
            x = x + mla_mixer(h, mla_w_q_a[b], mla_q_a_norm_g[b], mla_w_q_b[b], mla_w_out[b],
                              k_nope, k_rope, v_shared, cos, sin)
        x = x + sq_relu_mlp(rms_norm(x, norm_ffn_g[layer]), ffn_w_up[layer], ffn_w_down[layer])
        if layer == N_A_LAYERS - 1:
            k_nope, k_rope, v_shared = mla_shared_kv(x, kv_norm_g, mla_w_kv_a, mla_kv_a_norm_g,
                                                     mla_w_kv_b, cos, sin)
    return rms_norm(x, final_norm_g)
```

```cpp
#include <hip/hip_runtime.h>
#include <hip/hip_cooperative_groups.h>
#include <cstdio>
#include <cstdint>
namespace cg = cooperative_groups;
namespace pg8 {
#define PG8_LAS __attribute__((address_space(3)))
typedef unsigned short bf16_t;
typedef short bf16x8 __attribute__((ext_vector_type(8)));
typedef float f32x4 __attribute__((ext_vector_type(4)));
typedef unsigned u32x4 __attribute__((ext_vector_type(4)));
constexpr int BM = 256, BK = 64, HALF = 128, HTB = HALF * BK * 2  , STAGE_BYTES = 8 * HTB, NXCD = 8, WGM = 8;

__host__ __device__ __forceinline__ int lds_byte(int r, int c) { const int st = (r >> 4) * 2 + (c >> 5), rr = r & 15, cc = c & 31, ob = rr * 64 + cc * 2; return st * 1024 + (ob ^ (((ob >> 9) & 1) << 5)); }
__host__ __device__ __forceinline__ void stage_rc(int b, int& R, int& C) { const int st = b / 1024, sb = b % 1024, swz = sb ^ (((sb >> 9) & 1) << 5); R = (st >> 1) * 16 + swz / 64; C = (st & 1) * 32 + (swz % 64) / 2; }
__host__ __device__ __forceinline__ int perm32(int rho) { const int n = rho >> 4, i = rho & 15; return 8 * (i >> 2) + 4 * n + (i & 3); }

struct Unit { int pm, pn; };
struct Gemm { const bf16_t* A; const bf16_t* Bt; int M, N, K; };

struct StaticOrder {
    int nM, nN, nwg, G, c;
    __host__ __device__ void init(int M, int N, int G_, int c_) { nM = M / BM; nN = N / BM; nwg = nM * nN; G = G_; c = c_; }
    __host__ __device__ bool next(int i, Unit& u) const {
        const long L = (long)i * G + c; if (L >= nwg) return false;
        int wgid = (int)L; { const int q = nwg / NXCD, r = nwg % NXCD, xcd = wgid % NXCD, off = wgid / NXCD; wgid = (xcd < r ? xcd * (q + 1) : r * (q + 1) + (xcd - r) * q) + off; }
        const int nig = WGM * nN, gid = wgid / nig, fm = gid * WGM, gsz = (nM - fm) < WGM ? (nM - fm) : WGM;
        u.pm = fm + ((wgid % nig) % gsz); u.pn = (wgid % nig) / gsz; return true;
    }
    __device__ __forceinline__ void a_ready(const Unit&) const {}
    __device__ __forceinline__ void done(const Unit&) const {}
};

__device__ __forceinline__ unsigned cvt_pk_bf16(float lo, float hi) { unsigned r; asm volatile("v_cvt_pk_bf16_f32 %0, %1, %2" : "=v"(r) : "v"(lo), "v"(hi)); return r; }
typedef float f32x2 __attribute__((ext_vector_type(2)));
template <class Epi, class Sched, bool ALIGN_EPI = false, bool SP2 = false>
__device__ __forceinline__ void gemm_phase(PG8_LAS unsigned char* lds, const Gemm g, const Sched& S, const Epi& E) {
    int tid_ = threadIdx.x; asm volatile("" : "+v"(tid_));
    const int tid = tid_, wid = __builtin_amdgcn_readfirstlane(tid >> 6), lane = tid & 63, wr = wid >> 2, wc = wid & 3, fr = lane & 15, fq = lane >> 4;
    const int K = g.K, nt = K / BK;
    unsigned voffA[2], voffB[2];
#pragma unroll
    for (int i = 0; i < 2; ++i) { int R, C; stage_rc(tid * 16 + i * 8192, R, C); const int Rb = Epi::PERM ? ((R & ~31) + perm32(R & 31)) : R;
        voffA[i] = (unsigned)(R * K + C) * 2u; voffB[i] = (unsigned)(Rb * K + C) * 2u; }
    const size_t kstep = (size_t)(BK * 2);
    const size_t hstep = (size_t)HALF * K * 2;
    const size_t tstep = 2 * hstep;
    const unsigned ldsw = (unsigned)wid * 1024u;
    const int aoff = lds_byte(wr * 64 + fr, fq * 8), boff = lds_byte(wc * 32 + fr, fq * 8);
#define PG8_SA(b, h) (((b) * 2 + (h)) * HTB)
#define PG8_SB(b, h) ((4 + (b) * 2 + (h)) * HTB)
#define PG8_STAGE(bufoff, gbase, voff) do { _Pragma("unroll") for (int _i = 0; _i < 2; ++_i) \
        __builtin_amdgcn_global_load_lds((const unsigned*)((const char*)(gbase) + (voff)[_i]), (PG8_LAS unsigned*)(lds + (bufoff) + ldsw + _i * 8192), 16, 0, 0); } while (0)
#define PG8_LDA(dst, b, h) do { _Pragma("unroll") for (int m = 0; m < 4; ++m) _Pragma("unroll") for (int k = 0; k < 2; ++k) dst[m][k] = *(const PG8_LAS bf16x8*)(lds + PG8_SA(b, h) + aoff + m * 2048 + k * 1024); } while (0)
#define PG8_LDB(dst, b, h) do { _Pragma("unroll") for (int n = 0; n < 2; ++n) _Pragma("unroll") for (int k = 0; k < 2; ++k) dst[n][k] = *(const PG8_LAS bf16x8*)(lds + PG8_SB(b, h) + boff + n * 2048 + k * 1024); } while (0)
#define PG8_MMA(ai, bj, At, Bt) do { __builtin_amdgcn_s_setprio(1); _Pragma("unroll") for (int m = 0; m < 4; ++m) _Pragma("unroll") for (int n = 0; n < 2; ++n) _Pragma("unroll") for (int k = 0; k < 2; ++k) \
        acc[ai][bj][m][n] = __builtin_amdgcn_mfma_f32_16x16x32_bf16(Bt[n][k], At[m][k], acc[ai][bj][m][n], 0, 0, 0); __builtin_amdgcn_s_setprio(0); } while (0)
#define PG8_WAIT_V(n) asm volatile("s_waitcnt vmcnt(" #n ")" ::: "memory")
#define PG8_WAIT_L(n) asm volatile("s_waitcnt lgkmcnt(" #n ")" ::: "memory")
#define PG8_BAR __builtin_amdgcn_s_barrier()
#define PG8_SCHED __builtin_amdgcn_sched_barrier(0)
    Unit cur, nxt; int ui = 0;
    if (!S.next(0, cur)) return;
    f32x4 acc[2][2][4][2];
#pragma unroll
    for (int a = 0; a < 2; ++a)
#pragma unroll
        for (int b = 0; b < 2; ++b)
#pragma unroll
            for (int m = 0; m < 4; ++m)
#pragma unroll
                for (int n = 0; n < 2; ++n) acc[a][b][m][n] = (f32x4){0.f, 0.f, 0.f, 0.f};
    bf16x8 At[4][2], B0[2][2], B1[2][2];
    const char* cA = (const char*)g.A + (size_t)cur.pm * tstep; const char* cB = (const char*)g.Bt + (size_t)cur.pn * tstep;
    S.a_ready(cur);
    if constexpr (SP2) {
        PG8_STAGE(PG8_SB(0, 0), cB, voffB); PG8_STAGE(PG8_SB(0, 1), cB + hstep, voffB); PG8_STAGE(PG8_SA(0, 0), cA, voffA); PG8_STAGE(PG8_SA(0, 1), cA + hstep, voffA);
        if (wr == 1) PG8_BAR;
        PG8_WAIT_V(2); PG8_BAR;
        PG8_STAGE(PG8_SB(1, 0), cB + kstep, voffB); PG8_STAGE(PG8_SA(1, 0), cA + kstep, voffA); PG8_STAGE(PG8_SB(1, 1), cB + hstep + kstep, voffB);
        PG8_WAIT_V(6); PG8_BAR;
    } else {
        PG8_STAGE(PG8_SB(0, 0), cB, voffB); PG8_STAGE(PG8_SA(0, 0), cA, voffA); PG8_STAGE(PG8_SB(0, 1), cB + hstep, voffB); PG8_STAGE(PG8_SA(0, 1), cA + hstep, voffA);
        if (wr == 1) PG8_BAR;
        PG8_WAIT_V(4); PG8_BAR;
        PG8_STAGE(PG8_SB(1, 0), cB + kstep, voffB); PG8_STAGE(PG8_SA(1, 0), cA + kstep, voffA); PG8_STAGE(PG8_SB(1, 1), cB + hstep + kstep, voffB);
        PG8_WAIT_V(6); PG8_BAR;
    }
    for (;;) {
        const bool has_next = S.next(ui + 1, nxt);
        const char* nA = has_next ? (const char*)g.A + (size_t)nxt.pm * tstep : cA; const char* nB = has_next ? (const char*)g.Bt + (size_t)nxt.pn * tstep : cB;
#pragma unroll 1
        for (int t = 0; t < nt; t += 2) {
            const bool last = (t == nt - 2);
            const char* a1 = cA + (size_t)(t + 1) * kstep;
            const char* a2 = last ? nA : cA + (size_t)(t + 2) * kstep; const char* b2 = last ? nB : cB + (size_t)(t + 2) * kstep;
            const char* a3 = a2 + kstep; const char* b3 = b2 + kstep;
            if (last && has_next) S.a_ready(nxt);
            if constexpr (SP2) {
            PG8_LDB(B0, 0, 0); PG8_LDB(B1, 0, 1); PG8_SCHED; PG8_LDA(At, 0, 0); PG8_STAGE(PG8_SA(1, 1), a1 + hstep, voffA);
            PG8_WAIT_V(8); PG8_WAIT_L(0); PG8_BAR; PG8_MMA(0, 0, At, B0); PG8_MMA(0, 1, At, B1); PG8_BAR; PG8_SCHED;
            PG8_LDA(At, 0, 1); PG8_STAGE(PG8_SB(0, 0), b2, voffB); PG8_STAGE(PG8_SB(0, 1), b2 + hstep, voffB); PG8_STAGE(PG8_SA(0, 0), a2, voffA);
            PG8_WAIT_V(8); PG8_WAIT_L(0); PG8_BAR; PG8_MMA(1, 0, At, B0); PG8_MMA(1, 1, At, B1); PG8_BAR; PG8_SCHED;
            PG8_LDB(B0, 1, 0); PG8_LDB(B1, 1, 1); PG8_SCHED; PG8_LDA(At, 1, 0); PG8_STAGE(PG8_SA(0, 1), a2 + hstep, voffA);
            PG8_WAIT_V(8); PG8_WAIT_L(0); PG8_BAR; PG8_MMA(0, 0, At, B0); PG8_MMA(0, 1, At, B1); PG8_BAR; PG8_SCHED;
            PG8_LDA(At, 1, 1); PG8_STAGE(PG8_SB(1, 0), b3, voffB); PG8_STAGE(PG8_SB(1, 1), b3 + hstep, voffB); PG8_STAGE(PG8_SA(1, 0), a3, voffA);
            PG8_WAIT_V(8); PG8_WAIT_L(0); PG8_BAR; PG8_MMA(1, 0, At, B0); PG8_MMA(1, 1, At, B1); PG8_BAR; PG8_SCHED;
            } else {
            PG8_LDB(B0, 0, 0); PG8_SCHED; PG8_LDA(At, 0, 0); PG8_STAGE(PG8_SA(1, 1), a1 + hstep, voffA);
            PG8_WAIT_L(8); PG8_BAR; PG8_WAIT_L(0); PG8_MMA(0, 0, At, B0); PG8_BAR; PG8_SCHED;
            PG8_LDB(B1, 0, 1); PG8_STAGE(PG8_SB(0, 0), b2, voffB);
            PG8_BAR; PG8_WAIT_L(0); PG8_MMA(0, 1, At, B1); PG8_BAR;
            PG8_LDA(At, 0, 1); PG8_STAGE(PG8_SA(0, 0), a2, voffA);
            PG8_BAR; PG8_WAIT_L(0); PG8_MMA(1, 0, At, B0); PG8_BAR; PG8_SCHED;
            PG8_STAGE(PG8_SB(0, 1), b2 + hstep, voffB);
            PG8_WAIT_V(6); PG8_BAR; PG8_MMA(1, 1, At, B1); PG8_BAR;
            PG8_LDB(B0, 1, 0); PG8_SCHED; PG8_LDA(At, 1, 0); PG8_STAGE(PG8_SA(0, 1), a2 + hstep, voffA);
            PG8_WAIT_L(8); PG8_BAR; PG8_WAIT_L(0); PG8_MMA(0, 0, At, B0); PG8_BAR; PG8_SCHED;
            PG8_LDB(B1, 1, 1); PG8_STAGE(PG8_SB(1, 0), b3, voffB);
            PG8_BAR; PG8_WAIT_L(0); PG8_MMA(0, 1, At, B1); PG8_BAR;
            PG8_LDA(At, 1, 1); PG8_STAGE(PG8_SA(1, 0), a3, voffA);
            PG8_BAR; PG8_WAIT_L(0); PG8_MMA(1, 0, At, B0); PG8_BAR; PG8_SCHED;
            PG8_STAGE(PG8_SB(1, 1), b3 + hstep, voffB);
            PG8_WAIT_V(6); PG8_BAR; PG8_MMA(1, 1, At, B1); PG8_BAR;
            }
        }
        if constexpr (ALIGN_EPI) { if (wr == 0) PG8_BAR; }
        if constexpr (!Epi::AFTER_DRAIN) { E(acc, cur, wr, wc, fr, fq); S.done(cur); }
        if (!has_next) break;
#pragma unroll
        for (int a = 0; a < 2; ++a)
#pragma unroll
            for (int b = 0; b < 2; ++b)
#pragma unroll
                for (int m = 0; m < 4; ++m)
#pragma unroll
                    for (int n = 0; n < 2; ++n) acc[a][b][m][n] = (f32x4){0.f, 0.f, 0.f, 0.f};
        cur = nxt; cA = nA; cB = nB; ++ui;
        if constexpr (ALIGN_EPI) { if (wr == 1) PG8_BAR; }
    }
    PG8_WAIT_V(0);
    if constexpr (!ALIGN_EPI) { if (wr == 0) PG8_BAR; }
    PG8_BAR;
    if constexpr (Epi::AFTER_DRAIN) { E.fused(acc, cur, wr, wc, fr, fq, lds, wid, lane); S.done(cur); }
#undef PG8_SA
#undef PG8_SB
#undef PG8_STAGE
#undef PG8_LDA
#undef PG8_LDB
#undef PG8_MMA
#undef PG8_WAIT_V
#undef PG8_WAIT_L
#undef PG8_BAR
#undef PG8_SCHED
}
}
namespace pg8 {
typedef unsigned u32x2 __attribute__((ext_vector_type(2)));
constexpr float RMS_EPS = 1e-6f;
__device__ __forceinline__ u32x4 pack8(f32x4 a, f32x4 b) { u32x4 w; w.x = cvt_pk_bf16(a[0], a[1]); w.y = cvt_pk_bf16(a[2], a[3]); w.z = cvt_pk_bf16(b[0], b[1]); w.w = cvt_pk_bf16(b[2], b[3]); return w; }
__device__ __forceinline__ float sumsq8(f32x4 a, f32x4 b) { return (a[0] * a[0] + a[1] * a[1]) + (a[2] * a[2] + a[3] * a[3]) + (b[0] * b[0] + b[1] * b[1]) + (b[2] * b[2] + b[3] * b[3]); }
__device__ __forceinline__ void rope8(f32x4& v0, f32x4& v1, const float* tab) {
    const f32x4 t0 = *(const f32x4*)tab, t1 = *(const f32x4*)(tab + 4);
    f32x4 a, b;
    a[0] = v0[0] * t0[0] - v0[1] * t0[1]; a[1] = v0[1] * t0[0] + v0[0] * t0[1];
    a[2] = v0[2] * t0[2] - v0[3] * t0[3]; a[3] = v0[3] * t0[2] + v0[2] * t0[3];
    b[0] = v1[0] * t1[0] - v1[1] * t1[1]; b[1] = v1[1] * t1[0] + v1[0] * t1[1];
    b[2] = v1[2] * t1[2] - v1[3] * t1[3]; b[3] = v1[3] * t1[2] + v1[2] * t1[3];
    v0 = a; v1 = b;
}
__device__ __forceinline__ void row_rstd(float (&rs)[2][4], const float* ss, int row0, float invn, float mul) {
    float t[2][4];
#pragma unroll
    for (int ai = 0; ai < 2; ++ai)
#pragma unroll
        for (int m = 0; m < 4; ++m) t[ai][m] = ss[row0 + ai * HALF + m * 16];
#pragma unroll
    for (int ai = 0; ai < 2; ++ai)
#pragma unroll
        for (int m = 0; m < 4; ++m) rs[ai][m] = rsqrtf(t[ai][m] * invn + RMS_EPS) * mul;
}
__device__ __forceinline__ void row_rstd4(float (&rs)[4], const float* ss, int row0, float invn, float mul) {
    float t[4];
#pragma unroll
    for (int m = 0; m < 4; ++m) t[m] = ss[row0 + m * 16];
#pragma unroll
    for (int m = 0; m < 4; ++m) rs[m] = rsqrtf(t[m] * invn + RMS_EPS) * mul;
}
struct EpiQKV {
    static constexpr bool PERM = true, AFTER_DRAIN = false;
    bf16_t* Q; size_t tstride; bf16_t* V; const float* ss; float qscale;
    unsigned* kmax2;
    __device__ __forceinline__ void operator()(const f32x4 (&acc)[2][2][4][2], const Unit& u, int wr, int wc, int fr, int fq) const {
        const int t = u.pn >> 2; bf16_t* base = t < 2 ? Q + (size_t)t * tstride : V; const float sc = t == 0 ? qscale : 1.f;
        const int col0 = (u.pn & 3) * 256 + wc * 32 + 8 * fq;
        float rsv[2][4]; row_rstd(rsv, ss, u.pm * BM + wr * 64 + fr, 1.f / 1024.f, 1.f);
#pragma unroll
        for (int ai = 0; ai < 2; ++ai)
#pragma unroll
            for (int m = 0; m < 4; ++m) { const int row = u.pm * BM + ai * HALF + wr * 64 + m * 16 + fr; const float rs = rsv[ai][m] * sc;
                bf16_t* rowp = base + (size_t)row * 1024 + col0;
#pragma unroll
                for (int bj = 0; bj < 2; ++bj) *(u32x4*)(rowp + bj * HALF) = pack8(acc[ai][bj][m][0] * rs, acc[ai][bj][m][1] * rs); }
        if (t == 1) {
#pragma unroll
            for (int bj = 0; bj < 2; ++bj) { float mx = 0.f;
#pragma unroll
                for (int ai = 0; ai < 2; ++ai)
#pragma unroll
                    for (int m = 0; m < 4; ++m) { const float rs = rsv[ai][m];
                        float s8 = sumsq8(acc[ai][bj][m][0] * rs, acc[ai][bj][m][1] * rs); s8 += __shfl_xor(s8, 16); s8 += __shfl_xor(s8, 32); mx = fmaxf(mx, s8); }
                mx = fmaxf(mx, __shfl_xor(mx, 1)); mx = fmaxf(mx, __shfl_xor(mx, 2)); mx = fmaxf(mx, __shfl_xor(mx, 4)); mx = fmaxf(mx, __shfl_xor(mx, 8));
                if (fr == 0 && fq == 0) atomicMax(kmax2 + ((u.pm >> 5) * 16 + (u.pn & 3) * 4 + bj * 2 + (wc >> 1)) * 2 + (wc & 1), __float_as_uint(mx)); }
        }
    }
};
__device__ __forceinline__ void unpack8(const u32x4 w, f32x4& a, f32x4& b) {
    a[0] = __uint_as_float(w.x << 16); a[1] = __uint_as_float(w.x & 0xffff0000u); a[2] = __uint_as_float(w.y << 16); a[3] = __uint_as_float(w.y & 0xffff0000u);
    b[0] = __uint_as_float(w.z << 16); b[1] = __uint_as_float(w.z & 0xffff0000u); b[2] = __uint_as_float(w.w << 16); b[3] = __uint_as_float(w.w & 0xffff0000u);
}
struct EpiRes {
    static constexpr bool PERM = true, AFTER_DRAIN = false;
    const float* basef; bf16_t* xb; bf16_t* lo; float* ss;
    __device__ __forceinline__ void operator()(const f32x4 (&acc)[2][2][4][2], const Unit& u, int wr, int wc, int fr, int fq) const {
        const int col0 = u.pn * BM + wc * 32 + 8 * fq; const size_t lo_pan = (size_t)u.pm * 262144;
#pragma unroll
        for (int ai = 0; ai < 2; ++ai) {
            f32x4 bv[4][2][2];
#pragma unroll
            for (int m = 0; m < 4; ++m) { const size_t off = (size_t)(u.pm * BM + ai * HALF + wr * 64 + m * 16 + fr) * 1024 + col0;
#pragma unroll
                for (int bj = 0; bj < 2; ++bj) {
                    if (basef) { bv[m][bj][0] = *(const f32x4*)(basef + off + bj * HALF); bv[m][bj][1] = *(const f32x4*)(basef + off + bj * HALF + 4); }
                    else { const u32x4 hw = *(const u32x4*)(xb + off + bj * HALF); f32x4 h0, h1; unpack8(hw, h0, h1);
                        if (lo) { const u32x4 lw = *(const u32x4*)(lo + lo_pan + off + bj * HALF); f32x4 l0, l1; unpack8(lw, l0, l1); h0 += l0; h1 += l1; }
                        bv[m][bj][0] = h0; bv[m][bj][1] = h1; } } }
            asm volatile("" ::: "memory");
#pragma unroll
            for (int m = 0; m < 4; ++m) { const int row = u.pm * BM + ai * HALF + wr * 64 + m * 16 + fr; const size_t off = (size_t)row * 1024 + col0; float s = 0.f;
#pragma unroll
                for (int bj = 0; bj < 2; ++bj) { const size_t o2 = off + bj * HALF; const f32x4 o0 = bv[m][bj][0] + acc[ai][bj][m][0], o1 = bv[m][bj][1] + acc[ai][bj][m][1];
                    s += sumsq8(o0, o1);
                    const u32x4 hw = pack8(o0, o1); f32x4 h0, h1; unpack8(hw, h0, h1);
                    *(u32x4*)(xb + o2) = hw; if (lo) *(u32x4*)(lo + lo_pan + o2) = pack8(o0 - h0, o1 - h1); }
                s += __shfl_xor(s, 16); s += __shfl_xor(s, 32);
                if (fq == 0) atomicAdd(ss + row, s); }
            asm volatile("" ::: "memory");
        }
    }
};
struct EpiResFinal {
    static constexpr bool PERM = true, AFTER_DRAIN = true;
    const bf16_t* xb; const bf16_t* lo; float* out; float* ss; const float* g; unsigned* cnt;
    __device__ __forceinline__ void fused(f32x4 (&acc)[2][2][4][2], const Unit& u, int wr, int wc, int fr, int fq, PG8_LAS unsigned char* lds, int wid, int lane) const {
        const int col0 = u.pn * BM + wc * 32 + 8 * fq; const size_t lo_pan = (size_t)u.pm * 262144;
#pragma unroll
        for (int ai = 0; ai < 2; ++ai) {
            u32x4 hv[4][2], lv[4][2];
#pragma unroll
            for (int m = 0; m < 4; ++m) { const size_t off = (size_t)(u.pm * BM + ai * HALF + wr * 64 + m * 16 + fr) * 1024 + col0;
#pragma unroll
                for (int bj = 0; bj < 2; ++bj) { hv[m][bj] = *(const u32x4*)(xb + off + bj * HALF); lv[m][bj] = lo ? *(const u32x4*)(lo + lo_pan + off + bj * HALF) : (u32x4){0u, 0u, 0u, 0u}; } }
            asm volatile("" ::: "memory");
#pragma unroll
            for (int m = 0; m < 4; ++m) { const int row = u.pm * BM + ai * HALF + wr * 64 + m * 16 + fr; float s = 0.f;
#pragma unroll
                for (int bj = 0; bj < 2; ++bj) { f32x4 h0, h1, l0, l1; unpack8(hv[m][bj], h0, h1); unpack8(lv[m][bj], l0, l1);
                    const f32x4 o0 = (h0 + l0) + acc[ai][bj][m][0], o1 = (h1 + l1) + acc[ai][bj][m][1]; acc[ai][bj][m][0] = o0; acc[ai][bj][m][1] = o1; s += sumsq8(o0, o1); }
                s += __shfl_xor(s, 16); s += __shfl_xor(s, 32);
                if (fq == 0) atomicAdd(ss + row, s); }
            asm volatile("" ::: "memory");
        }
        asm volatile("s_waitcnt vmcnt(0)" ::: "memory");
        __syncthreads();
        if (wid == 0 && lane == 0) {
            __builtin_amdgcn_fence(__ATOMIC_RELEASE, "agent");
            unsigned* c = cnt + 64 * u.pm;
            __hip_atomic_fetch_add(c, 1u, __ATOMIC_RELAXED, __HIP_MEMORY_SCOPE_AGENT);
            unsigned spins = 0u;
            while (__hip_atomic_load(c, __ATOMIC_RELAXED, __HIP_MEMORY_SCOPE_AGENT) < 4u) { __builtin_amdgcn_s_sleep(2); if (++spins > (1u << 22)) break; }
            __builtin_amdgcn_fence(__ATOMIC_ACQUIRE, "agent");
        }
        __syncthreads();
        f32x4 gv[2][2];
#pragma unroll
        for (int bj = 0; bj < 2; ++bj)
#pragma unroll
            for (int n = 0; n < 2; ++n) gv[bj][n] = *(const f32x4*)(g + col0 + bj * HALF + n * 4);
        float ssv[2][4];
#pragma unroll
        for (int ai = 0; ai < 2; ++ai)
#pragma unroll
            for (int m = 0; m < 4; ++m) ssv[ai][m] = __hip_atomic_load(ss + u.pm * BM + ai * HALF + wr * 64 + m * 16 + fr, __ATOMIC_RELAXED, __HIP_MEMORY_SCOPE_AGENT);
#pragma unroll
        for (int ai = 0; ai < 2; ++ai)
#pragma unroll
            for (int m = 0; m < 4; ++m) { const int row = u.pm * BM + ai * HALF + wr * 64 + m * 16 + fr; const size_t off = (size_t)row * 1024 + col0; const float rstd = rsqrtf(ssv[ai][m] * (1.f / 1024.f) + RMS_EPS);
#pragma unroll
                for (int bj = 0; bj < 2; ++bj)
#pragma unroll
                    for (int n = 0; n < 2; ++n) *(f32x4*)(out + off + bj * HALF + n * 4) = acc[ai][bj][m][n] * rstd * gv[bj][n]; }
    }
};
struct EpiUp {
    static constexpr bool PERM = true, AFTER_DRAIN = false;
    bf16_t* H; const float* ss;
    __device__ __forceinline__ void operator()(const f32x4 (&acc)[2][2][4][2], const Unit& u, int wr, int wc, int fr, int fq) const {
        const int col0 = u.pn * BM + wc * 32 + 8 * fq;
        float rsv[2][4]; row_rstd(rsv, ss, u.pm * BM + wr * 64 + fr, 1.f / 1024.f, 1.f);
#pragma unroll
        for (int ai = 0; ai < 2; ++ai)
#pragma unroll
            for (int m = 0; m < 4; ++m) { const int row = u.pm * BM + ai * HALF + wr * 64 + m * 16 + fr; const float rs = rsv[ai][m];
                bf16_t* rowp = H + (size_t)row * 4096 + col0;
#pragma unroll
                for (int bj = 0; bj < 2; ++bj) { f32x4 a = acc[ai][bj][m][0] * rs, b = acc[ai][bj][m][1] * rs;
#pragma unroll
                    for (int j = 0; j < 4; ++j) { a[j] = fmaxf(a[j], 0.f); a[j] *= a[j]; b[j] = fmaxf(b[j], 0.f); b[j] *= b[j]; }
                    *(u32x4*)(rowp + bj * HALF) = pack8(a, b); } }
    }
};
struct EpiQKVA {
    static constexpr bool PERM = true, AFTER_DRAIN = false;
    bf16_t* CKV; bf16_t* QA; bf16_t* KR; const float* ss; float* ss_kv; float* ss_q; const float* rope;
    __device__ __forceinline__ void operator()(const f32x4 (&acc)[2][2][4][2], const Unit& u, int wr, int wc, int fr, int fq) const {
        const int cb = wc * 32 + 8 * fq;
        float rsv[2][4]; row_rstd(rsv, ss, u.pm * BM + wr * 64 + fr, 1.f / 1024.f, 1.f);
#pragma unroll
        for (int ai = 0; ai < 2; ++ai)
#pragma unroll
            for (int m = 0; m < 4; ++m) { const int row = u.pm * BM + ai * HALF + wr * 64 + m * 16 + fr; const float rs = rsv[ai][m];
                float s = 0.f;
#pragma unroll
                for (int bj = 0; bj < 2; ++bj) { f32x4 a = acc[ai][bj][m][0] * rs, b = acc[ai][bj][m][1] * rs;
                    if (u.pn == 0) { *(u32x4*)(CKV + (size_t)row * 256 + bj * HALF + cb) = pack8(a, b); s += sumsq8(a, b); }
                    else if (u.pn == 1) { *(u32x4*)(QA + (size_t)row * 384 + bj * HALF + cb) = pack8(a, b); s += sumsq8(a, b); }
                    else if (bj == 0) { *(u32x4*)(QA + (size_t)row * 384 + 256 + cb) = pack8(a, b); s += sumsq8(a, b); }
                    else if (wc < 2) { rope8(a, b, rope + ((size_t)(row & 8191) * 32 + (cb >> 1)) * 2); *(u32x4*)(KR + (size_t)row * 64 + cb) = pack8(a, b); } }
                s += __shfl_xor(s, 16); s += __shfl_xor(s, 32);
                if (fq == 0) atomicAdd((u.pn == 0 ? ss_kv : ss_q) + row, s); }
    }
};
struct EpiKVB {
    static constexpr bool PERM = true, AFTER_DRAIN = false;
    bf16_t* KV; const float* ss_kv;
    __device__ __forceinline__ void operator()(const f32x4 (&acc)[2][2][4][2], const Unit& u, int wr, int wc, int fr, int fq) const {
        const int col0 = u.pn * BM + wc * 32 + 8 * fq;
#pragma unroll
        for (int ai = 0; ai < 2; ++ai) { float rs4[4]; row_rstd4(rs4, ss_kv, u.pm * BM + ai * HALF + wr * 64 + fr, 1.f / 256.f, 1.f);
#pragma unroll
            for (int m = 0; m < 4; ++m) { const int row = u.pm * BM + ai * HALF + wr * 64 + m * 16 + fr; const float rs = rs4[m];
                bf16_t* rowp = KV + (size_t)row * 2048 + col0;
#pragma unroll
                for (int bj = 0; bj < 2; ++bj) *(u32x4*)(rowp + bj * HALF) = pack8(acc[ai][bj][m][0] * rs, acc[ai][bj][m][1] * rs); }
            asm volatile("" ::: "memory"); }
    }
};
struct EpiQB {
    static constexpr bool PERM = true, AFTER_DRAIN = false;
    bf16_t* Q; const float* ss_q; float qscale;
    __device__ __forceinline__ void operator()(const f32x4 (&acc)[2][2][4][2], const Unit& u, int wr, int wc, int fr, int fq) const {
        const int col0 = u.pn * BM + wc * 32 + 8 * fq;
#pragma unroll
        for (int ai = 0; ai < 2; ++ai) { float rs4[4]; row_rstd4(rs4, ss_q, u.pm * BM + ai * HALF + wr * 64 + fr, 1.f / 384.f, qscale);
#pragma unroll
            for (int m = 0; m < 4; ++m) { const int row = u.pm * BM + ai * HALF + wr * 64 + m * 16 + fr; const float rs = rs4[m];
                bf16_t* rowp = Q + (size_t)row * 1536 + col0;
#pragma unroll
                for (int bj = 0; bj < 2; ++bj) { f32x4 a = acc[ai][bj][m][0] * rs, b = acc[ai][bj][m][1] * rs;
                    *(u32x4*)(rowp + bj * HALF) = pack8(a, b); } }
            asm volatile("" ::: "memory"); }
    }
};
}
namespace att {
typedef unsigned short bf16_t;
typedef short bf16x8 __attribute__((ext_vector_type(8)));
typedef short s16x4 __attribute__((ext_vector_type(4)));
typedef float f32x16 __attribute__((ext_vector_type(16)));
typedef float f32x4 __attribute__((ext_vector_type(4)));
typedef unsigned u32x4 __attribute__((ext_vector_type(4)));
#define ASBAR() __builtin_amdgcn_sched_barrier(0)
constexpr double LOG2E_D = 1.4426950408889634;
__device__ __forceinline__ int v_st(int k, int c) { const int kk = (k & ~0xC) | ((k & 4) << 1) | ((k & 8) >> 1); return ((kk >> 3) * 4 + (c >> 5)) * 512 + ((kk & 7) * 32 + (c & 31)) * 2; }
__device__ __forceinline__ int v_rd_base(int lane) { return ((lane & 3) << 3) | (((lane >> 2) & 3) << 6) | (((lane >> 4) & 1) << 5) | (((lane >> 5) & 1) << 8); }
__device__ __forceinline__ int crow(int r, int hi) { return (r & 3) + 8 * (r >> 2) + 4 * hi; }
__device__ __forceinline__ unsigned cvtpk(float lo, float hi) { unsigned r; asm volatile("v_cvt_pk_bf16_f32 %0, %1, %2" : "=v"(r) : "v"(lo), "v"(hi)); return r; }

struct Unit {
    const bf16_t* q[2]; int qs;
    const bf16_t* kA; int ksA;
    const bf16_t* kB; int ksB;
    const bf16_t* v; int vs;
    bf16_t* o; int os;
    const double* c;
    const unsigned* kmax2;
    const float* rtab;
    int q0, j_lo;
};
template <int DQK, int DV, bool BIAS> struct Lay {
    static constexpr int KROWB = DQK * 2, SHM_K = 64 * KROWB, SHM_V = 16384;
    static constexpr int OFF_K = 2 * SHM_V, OFF_WS = OFF_K + 2 * SHM_K, OFF_CK = OFF_WS + 2048, BYTES = OFF_CK + 32768;
};

template <int DQK, int DV, bool BIAS>
__device__ __forceinline__ void attn_unit(const Unit& U, char* lds) {
    typedef Lay<DQK, DV, BIAS> L;
    constexpr int NKB = DQK / 64, NVB = DV / 64, NQF = DQK / 16, NOD = DV / 32, KROWB = L::KROWB, SHM_K = L::SHM_K, SHM_V = L::SHM_V;
    int tid_ = threadIdx.x; asm volatile("" : "+v"(tid_));
    const int tid = tid_, wid = __builtin_amdgcn_readfirstlane(tid >> 6), lane = tid & 63, r32 = lane & 31, hi = lane >> 5;
    char* V_lds = lds; char* K_lds = lds + L::OFF_K;
    float* ws = (float*)(lds + L::OFF_WS) + wid * 64; float* li_l = ws; float* al_l = ws + 32;
    float* ckL = (float*)(lds + L::OFF_CK);
    const int q0 = U.q0;
    const int qlo = q0 + wid * 32, qrow = qlo + r32, qm = qrow - 4 * hi;
    const int vb0 = (int)(uintptr_t)V_lds + v_rd_base(lane);
    const unsigned lds0 = (unsigned)(uintptr_t)lds;
    const bf16_t* ksrc[NKB]; int kstep[NKB]; const bf16_t* vsrc[NVB];
#define A_SRCSETUP(KLO_) do { \
_Pragma("unroll") \
    for (int i = 0; i < NKB; ++i) { const int B_ = (wid * NKB + i) * 1024 + lane * 16, row = B_ / KROWB, ph = (B_ % KROWB) >> 4, lg = (ph & ~7) | ((ph & 7) ^ ((row >> 1) & 7)), col = lg * 8, blk = col >> 6; \
        const bool hiB = blk >= 2; const int st_ = hiB ? U.ksB : U.ksA; const size_t eo_ = (size_t)((KLO_) + row) * st_ + (hiB ? col - 128 : col); \
        ksrc[i] = (hiB ? U.kB : U.kA) + eo_; kstep[i] = 64 * st_; } \
_Pragma("unroll") \
    for (int i = 0; i < NVB; ++i) { const int B_ = (wid * NVB + i) * (DV == 64 ? 2048 : 1024) + lane * 16, st_ = B_ >> 9, e_ = (B_ & 511) >> 1, kk_ = (st_ >> 2) * 8 + (e_ >> 5); \
        const int k_ = (kk_ & ~0xC) | ((kk_ & 4) << 1) | ((kk_ & 8) >> 1), c_ = (st_ & 3) * 32 + (e_ & 31); \
        vsrc[i] = U.v + (size_t)((KLO_) + k_) * U.vs + c_; } \
    } while (0)
#define A_GLDS(gsrc, ldsdst) do { unsigned keep_; asm volatile("s_mov_b32 %0, m0\n\ts_mov_b32 m0, %2\n\ts_nop 0\n\tglobal_load_lds_dwordx4 %1, off\n\ts_mov_b32 m0, %0" : "=&s"(keep_) : "v"(gsrc), "s"(ldsdst) : "memory"); } while (0)
#define A_DMA(bf) do { \
        _Pragma("unroll") for (int i_ = 0; i_ < NKB; ++i_) { A_GLDS(ksrc[i_], (unsigned)__builtin_amdgcn_readfirstlane(lds0 + L::OFF_K + (bf) * SHM_K + (wid * NKB + i_) * 1024)); ksrc[i_] += kstep[i_]; } \
        _Pragma("unroll") for (int i_ = 0; i_ < NVB; ++i_) { A_GLDS(vsrc[i_], (unsigned)__builtin_amdgcn_readfirstlane(lds0 + (bf) * SHM_V + (wid * NVB + i_) * (DV == 64 ? 2048 : 1024))); vsrc[i_] += 64 * U.vs; } } while (0)
#define A_DMAWAIT() asm volatile("s_waitcnt vmcnt(0)" ::: "memory")
    double c0_ = 0.0, cqd_ = 0.0, csk_ = 0.0; unsigned k2a_ = 0u, k2b_ = 0u;
    if constexpr (BIAS) { c0_ = U.c[U.q0]; cqd_ = U.c[U.q0 + wid * 32 + r32]; if (tid < U.q0 / 64) csk_ = U.c[64 * tid + 63]; k2a_ = U.kmax2[0]; k2b_ = U.kmax2[1]; }
    else { A_SRCSETUP(U.j_lo * 64); A_DMA(0); }
    bf16x8 qr[NQF];
#pragma unroll
    for (int d0 = 0; d0 < NQF; ++d0) qr[d0] = *(const bf16x8*)(U.q[d0 >> 3] + (size_t)qrow * U.qs + (d0 & 7) * 16 + hi * 8);
    if constexpr (DQK == 192) {
#pragma unroll
        for (int d0 = 8; d0 < 12; ++d0) { const float* tab = U.rtab + ((size_t)qrow * 32 + 8 * (d0 - 8) + 4 * hi) * 2; const f32x4 t0 = *(const f32x4*)tab, t1 = *(const f32x4*)(tab + 4);
            const u32x4 w = *reinterpret_cast<const u32x4*>(&qr[d0]); u32x4 ov;
#pragma unroll
            for (int j = 0; j < 4; ++j) { const float a = __uint_as_float(w[j] << 16), b = __uint_as_float(w[j] & 0xffff0000u); const float c_ = j < 2 ? t0[2 * (j & 1)] : t1[2 * (j & 1)], s_ = j < 2 ? t0[2 * (j & 1) + 1] : t1[2 * (j & 1) + 1];
                ov[j] = cvtpk(a * c_ - b * s_, b * c_ + a * s_); }
            qr[d0] = *reinterpret_cast<const bf16x8*>(&ov); }
        char* qL_ = lds + L::OFF_CK + wid * 4096 + lane * 16;
#pragma unroll
        for (int d0 = 8; d0 < 12; ++d0) { *(bf16x8*)(qL_ + (d0 - 8) * 1024) = qr[d0]; }
        asm volatile("" ::: "memory"); }
    const char* qL = lds + L::OFF_CK + wid * 4096 + lane * 16;
    int j_lo = U.j_lo;
    if constexpr (BIAS) {
        float qn2 = 0.f;
#pragma unroll
        for (int d0 = 0; d0 < NQF; ++d0) { const u32x4 w = *reinterpret_cast<const u32x4*>(&qr[d0]);
#pragma unroll
            for (int j = 0; j < 4; ++j) { const float a = __uint_as_float(w[j] << 16), b = __uint_as_float(w[j] & 0xffff0000u); qn2 += a * a + b * b; } }
        { auto rr = __builtin_amdgcn_permlane32_swap(__float_as_uint(qn2), __float_as_uint(qn2), false, false); qn2 = __uint_as_float(rr[0]) + __uint_as_float(rr[1]); }
#pragma unroll
        for (int o_ = 1; o_ < 32; o_ <<= 1) qn2 = fmaxf(qn2, __shfl_xor(qn2, o_));
        float* wsb = (float*)(lds + L::OFF_WS);
        if (lane == 0) wsb[wid * 64] = qn2;
        __syncthreads();
        float qmax2 = wsb[0];
#pragma unroll
        for (int w = 1; w < 8; ++w) qmax2 = fmaxf(qmax2, wsb[w * 64]);
        const float k2 = __uint_as_float(k2a_) + __uint_as_float(k2b_);
        const float thr = 2.f * (sqrtf(qmax2 * k2) * 1.02f + 1e-3f) + 160.f;
        const int nprev = q0 / 64;
        bool sk = false; if (tid < nprev) sk = (float)((csk_ - c0_) * LOG2E_D) > thr;
        const unsigned long long bal = __ballot(sk);
        if (lane == 0) ((int*)wsb)[wid * 64 + 1] = __popcll(bal);
        __syncthreads();
        int cnt = 0;
#pragma unroll
        for (int w = 0; w < 8; ++w) cnt += ((int*)wsb)[w * 64 + 1];
        j_lo = cnt;
    }
    const int klo = j_lo * 64, NT = (q0 + 256) / 64 - j_lo;
    float cq = 0.f;
    if constexpr (BIAS) { A_SRCSETUP(klo); A_DMA(0);
        const double cref = c0_; cq = (float)((cqd_ - cref) * LOG2E_D);
        for (int s = klo + tid; s < q0 + 256; s += 512) ckL[s - klo] = (float)((U.c[s] - cref) * LOG2E_D); }
    A_DMAWAIT();
    __syncthreads();
    float mhat = 0.f, l_reg = 0.f; f32x16 o[NOD]; f32x16 negm = f32x16{}; asm volatile("" : "+v"(negm));
#pragma unroll
    for (int d = 0; d < NOD; ++d) o[d] = f32x16{};
    const char* kbase = K_lds + r32 * KROWB;
    const int ksw = ((r32 >> 1) & 7) << 4;
#define A_TRRD(dst, off) asm volatile("ds_read_b64_tr_b16 %0, %1 offset:%2" : "=&v"(dst) : "v"(vb0), "i"(off) : "memory")
#define A_PV_RD(X, d0, BUF) do { constexpr int b_ = (BUF) * SHM_V + (d0) * 512; \
        A_TRRD(X##l0, b_); A_TRRD(X##h0, b_ + 2048); A_TRRD(X##l1, b_ + 4096); A_TRRD(X##h1, b_ + 6144); A_TRRD(X##l2, b_ + 8192); A_TRRD(X##h2, b_ + 10240); A_TRRD(X##l3, b_ + 12288); A_TRRD(X##h3, b_ + 14336); } while (0)
#define A_PV_MM(X, d0) do { \
        o[d0] = __builtin_amdgcn_mfma_f32_32x32x16_bf16(pa0, (bf16x8){X##l0[0], X##l0[1], X##l0[2], X##l0[3], X##h0[0], X##h0[1], X##h0[2], X##h0[3]}, o[d0], 0, 0, 0); \
        o[d0] = __builtin_amdgcn_mfma_f32_32x32x16_bf16(pa1, (bf16x8){X##l1[0], X##l1[1], X##l1[2], X##l1[3], X##h1[0], X##h1[1], X##h1[2], X##h1[3]}, o[d0], 0, 0, 0); \
        o[d0] = __builtin_amdgcn_mfma_f32_32x32x16_bf16(pa2, (bf16x8){X##l2[0], X##l2[1], X##l2[2], X##l2[3], X##h2[0], X##h2[1], X##h2[2], X##h2[3]}, o[d0], 0, 0, 0); \
        o[d0] = __builtin_amdgcn_mfma_f32_32x32x16_bf16(pa3, (bf16x8){X##l3[0], X##l3[1], X##l3[2], X##l3[3], X##h3[0], X##h3[1], X##h3[2], X##h3[3]}, o[d0], 0, 0, 0); } while (0)
#define A_LGKM(n) do { asm volatile("s_waitcnt lgkmcnt(" #n ")" ::: "memory"); ASBAR(); } while (0)
#define A_PV_ALL(BUF) do { s16x4 al0, al1, al2, al3, ah0, ah1, ah2, ah3, bl0, bl1, bl2, bl3, bh0, bh1, bh2, bh3; \
        A_PV_RD(a, 0, BUF); A_PV_RD(b, 1, BUF); A_LGKM(8); A_PV_MM(a, 0); ASBAR(); \
        if constexpr (NOD > 2) { A_PV_RD(a, 2 % NOD, BUF); A_LGKM(8); A_PV_MM(b, 1); ASBAR(); A_PV_RD(b, 3 % NOD, BUF); A_LGKM(8); A_PV_MM(a, 2 % NOD); ASBAR(); A_LGKM(0); A_PV_MM(b, 3 % NOD); } \
        else { A_LGKM(0); A_PV_MM(b, 1); } } while (0)
#define A_PK4(P, B_, OUT) do { unsigned a0 = cvtpk(P[B_ + 0], P[B_ + 1]), a1 = cvtpk(P[B_ + 2], P[B_ + 3]); unsigned b0 = cvtpk(P[B_ + 4], P[B_ + 5]), b1 = cvtpk(P[B_ + 6], P[B_ + 7]); \
        auto r0 = __builtin_amdgcn_permlane32_swap(a0, b0, false, false); auto r1 = __builtin_amdgcn_permlane32_swap(a1, b1, false, false); \
        u32x4 w = {r0[0], r1[0], r0[1], r1[1]}; OUT = *reinterpret_cast<bf16x8*>(&w); } while (0)
#define A_TILE(BUF, t, FIRST) do { \
        const int kb_ = klo + (t) * 64; const bool more_ = (t) + 1 < NT; \
        if (more_) A_DMA(1 - (BUF)); \
        ASBAR(); \
        f32x16 p0, p1; \
        _Pragma("unroll") for (int d0 = 0; d0 < NQF; ++d0) { const char* a_ = kbase + (BUF) * SHM_K + (d0 >> 2) * 128 + ((((d0 & 3) * 32) + hi * 16) ^ ksw); \
            const bf16x8 b0 = *(const bf16x8*)a_; const bf16x8 b1 = *(const bf16x8*)(a_ + 32 * KROWB); \
            const bf16x8 qf_ = d0 < 8 ? qr[d0 < 8 ? d0 : 0] : *(const bf16x8*)(qL + (d0 - 8) * 1024); \
            if (d0 == 0) { p0 = __builtin_amdgcn_mfma_f32_32x32x16_bf16(b0, qf_, negm, 0, 0, 0); p1 = __builtin_amdgcn_mfma_f32_32x32x16_bf16(b1, qf_, negm, 0, 0, 0); } \
            else { p0 = __builtin_amdgcn_mfma_f32_32x32x16_bf16(b0, qf_, p0, 0, 0, 0); p1 = __builtin_amdgcn_mfma_f32_32x32x16_bf16(b1, qf_, p1, 0, 0, 0); } if ((d0 & 1) == 1) ASBAR(); } \
        ASBAR(); \
        if constexpr (BIAS) { const float* ck_ = ckL + (kb_ - klo) + 4 * hi; \
            _Pragma("unroll") for (int g = 0; g < 4; ++g) { const f32x4 c0 = *(const f32x4*)(ck_ + 8 * g), c1 = *(const f32x4*)(ck_ + 32 + 8 * g); \
                _Pragma("unroll") for (int j = 0; j < 4; ++j) { p0[4 * g + j] += cq - c0[j]; p1[4 * g + j] += cq - c1[j]; } } } \
        if (kb_ + 63 > qlo) { const float NEG = -__builtin_inff(); const int dq = qm - kb_; \
            _Pragma("unroll") for (int r = 0; r < 16; ++r) { const int c = (r & 3) + 8 * (r >> 2); if (dq - c < 0) p0[r] = NEG; if (dq - c - 32 < 0) p1[r] = NEG; } } \
        float pmax = __builtin_fmaxf(__builtin_fmaxf(p0[0], p0[1]), p1[0]); float pmb = __builtin_fmaxf(__builtin_fmaxf(p0[2], p0[3]), p1[1]); pmax = __builtin_fmaxf(__builtin_fmaxf(pmax, p1[2]), p1[3]); \
        _Pragma("unroll") for (int r = 4; r < 16; r += 4) { pmax = __builtin_fmaxf(__builtin_fmaxf(pmax, p0[r]), p0[r + 1]); pmb = __builtin_fmaxf(__builtin_fmaxf(pmb, p0[r + 2]), p0[r + 3]); \
            pmax = __builtin_fmaxf(__builtin_fmaxf(pmax, p1[r]), p1[r + 1]); pmb = __builtin_fmaxf(__builtin_fmaxf(pmb, p1[r + 2]), p1[r + 3]); } \
        pmax = __builtin_fmaxf(pmax, pmb); \
        { auto rr = __builtin_amdgcn_permlane32_swap(__float_as_uint(pmax), __float_as_uint(pmax), false, false); pmax = fmaxf(__uint_as_float(rr[0]), __uint_as_float(rr[1])); } \
        if ((FIRST) || __any(pmax > 8.f)) { const float dl = (FIRST) ? pmax : fmaxf(pmax, 0.f); mhat += dl; \
            _Pragma("unroll") for (int r = 0; r < 16; ++r) { p0[r] -= dl; p1[r] -= dl; } \
            _Pragma("unroll") for (int r = 0; r < 16; ++r) negm[r] = -mhat; asm volatile("" : "+v"(negm)); \
            if (!(FIRST)) { const float alpha = __builtin_amdgcn_exp2f(-dl); l_reg *= alpha; if (hi == 0) al_l[r32] = alpha; asm volatile("s_waitcnt lgkmcnt(0)" ::: "memory"); \
                _Pragma("unroll") for (int d_ = 0; d_ < NOD; ++d_) _Pragma("unroll") for (int r = 0; r < 16; ++r) o[d_][r] *= al_l[crow(r, hi)]; } } \
        _Pragma("unroll") for (int r = 0; r < 16; ++r) { p0[r] = __builtin_amdgcn_exp2f(p0[r]); p1[r] = __builtin_amdgcn_exp2f(p1[r]); } \
        { const f32x16 sv = p0 + p1; float ps = ((sv[0] + sv[1]) + (sv[2] + sv[3])) + ((sv[4] + sv[5]) + (sv[6] + sv[7])) + (((sv[8] + sv[9]) + (sv[10] + sv[11])) + ((sv[12] + sv[13]) + (sv[14] + sv[15]))); \
          auto rr = __builtin_amdgcn_permlane32_swap(__float_as_uint(ps), __float_as_uint(ps), false, false); l_reg += __uint_as_float(rr[0]) + __uint_as_float(rr[1]); } \
        bf16x8 pa0, pa1, pa2, pa3; A_PK4(p0, 0, pa0); A_PK4(p0, 8, pa1); A_PK4(p1, 0, pa2); A_PK4(p1, 8, pa3); \
        ASBAR(); \
        A_PV_ALL(BUF); \
        A_DMAWAIT(); \
        __syncthreads(); } while (0)
    A_TILE(0, 0, true);
    int t = 1;
    for (; t + 1 < NT; t += 2) { A_TILE(1, t, false); A_TILE(0, t + 1, false); }
    if (t < NT) { A_TILE(1, t, false); }
    if (hi == 0) li_l[r32] = l_reg; asm volatile("s_waitcnt lgkmcnt(0)" ::: "memory");
    bf16_t* Ow = U.o + (size_t)qlo * U.os;
#pragma unroll
    for (int r = 0; r < 16; ++r) { const int orow = crow(r, hi); const float rl = __builtin_amdgcn_rcpf(li_l[orow]);
#pragma unroll
        for (int d0 = 0; d0 < NOD; ++d0) { const float v = o[d0][r] * rl; const float vn = __shfl_xor(v, 1);
            if ((r32 & 1) == 0) *(unsigned*)(Ow + (size_t)orow * U.os + d0 * 32 + r32) = cvtpk(v, vn); } }
    __syncthreads();
#undef A_GLDS
#undef A_SRCSETUP
#undef A_DMA
#undef A_DMAWAIT
#undef A_TRRD
#undef A_PV_RD
#undef A_PV_MM
#undef A_PV_ALL
#undef A_LGKM
#undef A_PK4
#undef A_TILE
}
}
#define LAS __attribute__((address_space(3)))
#define XB_TMO      128
#define XB_XCNT(j)  (256  + 64 * (j))
#define XB_XSUB(j)  (1280 + 64 * (j))
#define XB_XGEN(j)  (2304 + 64 * (j))
#define XB_TOP      3328
#define XB_TOPGEN   3392
#define XCD_BAR_WORDS 3456
#define XB_SPIN_CAP (1u << 18)

__device__ __forceinline__ unsigned xb_ld(unsigned* p)              { return __hip_atomic_load(p, __ATOMIC_RELAXED, __HIP_MEMORY_SCOPE_AGENT); }
__device__ __forceinline__ unsigned xb_add(unsigned* p, unsigned v) { return __hip_atomic_fetch_add(p, v, __ATOMIC_RELAXED, __HIP_MEMORY_SCOPE_AGENT); }
__device__ __forceinline__ unsigned xb_xcc_id() { return (unsigned)__builtin_amdgcn_s_getreg((3 << 11) | 20) & 0xFu; }
#define XB_SPIN(cond, bar) do { unsigned _sp = 0; while (cond) { __builtin_amdgcn_s_sleep(1); \
    if ((++_sp & 255u) == 0u) { if (xb_ld(&(bar)[XB_TMO])) break; if (_sp > XB_SPIN_CAP) { atomicAdd(&(bar)[XB_TMO], 1u); break; } } } } while (0)

struct XcdBarrier {
    unsigned* bar; unsigned x;
    volatile LAS unsigned* st;
};

__device__ __forceinline__ XcdBarrier xcd_barrier_post(unsigned* bar, volatile LAS unsigned* st) {
    XcdBarrier b; b.bar = bar; b.x = xb_xcc_id(); b.st = st;
    if (threadIdx.x == 0) (void)xb_add(&bar[XB_XCNT(b.x)], 1u);
    return b;
}
__device__ __forceinline__ void xcd_barrier_complete(unsigned* bar, unsigned x, unsigned& nloc, unsigned& nx) {
    const unsigned G = gridDim.x * gridDim.y * gridDim.z;
    unsigned sum, cnt, mine, sp = 0u;
    for (;;) {
        sum = 0u; cnt = 0u; mine = 0u;
#pragma unroll
        for (unsigned j = 0; j < 16; ++j) { const unsigned c = xb_ld(&bar[XB_XCNT(j)]); sum += c; cnt += (c > 0u) ? 1u : 0u; mine = (j == x) ? c : mine; }
        if (sum == G) break;
        __builtin_amdgcn_s_sleep(1);
        if ((++sp & 255u) == 0u) { if (xb_ld(&bar[XB_TMO])) break; if (sp > XB_SPIN_CAP) { atomicAdd(&bar[XB_TMO], 1u); break; } }
    }
    nloc = mine > 0u ? mine : 1u; nx = cnt > 0u ? cnt : 1u;
}

__device__ __forceinline__ void xcd_barrier(const XcdBarrier& b) {
    asm volatile("s_waitcnt vmcnt(0)" ::: "memory");
    __syncthreads();
    if (threadIdx.x == 0) {
        unsigned* bar = b.bar;
        __builtin_amdgcn_s_waitcnt(0);
        unsigned nloc = b.st[0], nx = b.st[1];
        if (nloc == 0u) { xcd_barrier_complete(bar, b.x, nloc, nx); b.st[0] = nloc; b.st[1] = nx; }
        const unsigned old = xb_add(&bar[XB_XSUB(b.x)], 1u);
        const unsigned gen = old / nloc;
        if (old + 1u == (gen + 1u) * nloc) {
            __builtin_amdgcn_fence(__ATOMIC_RELEASE, "agent");
            asm volatile("s_waitcnt vmcnt(0)" ::: "memory");
            const unsigned og = xb_add(&bar[XB_TOP], 1u);
            const unsigned tg = og / nx;
            if (og + 1u == (tg + 1u) * nx) xb_add(&bar[XB_TOPGEN], 1u);
            else XB_SPIN(xb_ld(&bar[XB_TOPGEN]) == tg, bar);
            __builtin_amdgcn_fence(__ATOMIC_ACQUIRE, "agent");
            xb_add(&bar[XB_XGEN(b.x)], 1u);
            asm volatile("s_waitcnt vmcnt(0)" ::: "memory");
        } else {
            XB_SPIN(xb_ld(&bar[XB_XGEN(b.x)]) == gen, bar);
            __builtin_amdgcn_fence(__ATOMIC_ACQUIRE, "agent");
            asm volatile("s_waitcnt vmcnt(0)" ::: "memory");
        }
    }
    __syncthreads();
}
typedef unsigned short bf16;
typedef unsigned v4u __attribute__((ext_vector_type(4)));
typedef float f32x4 __attribute__((ext_vector_type(4)));
constexpr int NWAVES = 8, M = 16384, SEQ = 8192, D = 1024, FF = 4096;
constexpr float RMS_EPS = 1e-6f;
constexpr float C2_FOX = 0.125f * 1.4426950408889634f;
constexpr float C2_MLA = 0.07216878364870323f * 1.4426950408889634f;
constexpr size_t MiB = 1u << 20;
constexpr size_t WS_CTL = 0, CTL_ZERO_BYTES = 1 * MiB;
constexpr size_t WS_ROPE = 1 * MiB, WS_LF = 3 * MiB, WS_C = 4 * MiB;
constexpr size_t WS_W = 8 * MiB;
constexpr size_t W_FIN = WS_W, W_FOUT = W_FIN + 6 * MiB, W_QKVA = W_FOUT + 2 * MiB, W_KVB = W_QKVA + 2 * MiB, W_QB = W_KVB + 1 * MiB, W_MOUT = W_QB + 2 * MiB,
                 W_UP0 = W_MOUT + 2 * MiB, W_UP1 = W_UP0 + 8 * MiB, W_DN0 = W_UP1 + 8 * MiB, W_DN1 = W_DN0 + 8 * MiB, W_END = W_DN1 + 8 * MiB;
constexpr size_t WS_XB = 56 * MiB;
constexpr size_t WS_H = 88 * MiB;
constexpr size_t WS_MKV = 88 * MiB, WS_MQ = 152 * MiB, WS_MKR = 248 * MiB  , WS_MO = 216 * MiB  , WS_CKV = 234 * MiB, WS_QA = 242 * MiB, WS_END = 254 * MiB;
static_assert(W_END <= WS_XB, "weights");
constexpr int SS_WORDS = 16384;
enum { SS0 = 1, SS1 = 2, SS2 = 3, SSKV = 4, SSQ = 5, SS3 = 6, SS4 = 7 };
constexpr int LDS_BYTES = 147456;

#define LDS_WAIT() asm volatile("s_waitcnt lgkmcnt(0)" ::: "memory")
__device__ __forceinline__ unsigned f2bf(float f) { unsigned u = __builtin_bit_cast(unsigned, f); return (u + 0x7fffu + ((u >> 16) & 1u)) >> 16; }
__device__ __forceinline__ unsigned pk2(float lo, float hi) { return f2bf(lo) | (f2bf(hi) << 16); }
__device__ __forceinline__ float wave_sum(float v) {
#pragma unroll
    for (int o = 1; o < 64; o <<= 1) v += __shfl_xor(v, o);
    return v;
}
__device__ __forceinline__ double wave_sum_d(double v) {
#pragma unroll
    for (int o = 1; o < 64; o <<= 1) { const int thi = __shfl_xor(__double2hiint(v), o), tlo = __shfl_xor(__double2loint(v), o); v += __hiloint2double(thi, tlo); }
    return v;
}
__device__ __forceinline__ void tr_item2(const float* W, int ldw, int srccol  , const float* g, int K, int k0, int n0, bf16* WT, LAS float* scr, int lane) {
    float t[32];
    const float* colp = W + (size_t)(k0 + (lane >> 5)) * ldw + (srccol < 0 ? 0 : srccol);
#pragma unroll
    for (int i = 0; i < 32; ++i) t[i] = colp[(size_t)(2 * i) * ldw];
    const float zf = srccol < 0 ? 0.f : 1.f;
#pragma unroll
    for (int i = 0; i < 32; ++i) scr[(2 * i + (lane >> 5)) * 33 + (lane & 31)] = t[i] * zf;
    const int c = lane & 7;
    f32x4 ga = {1.f, 1.f, 1.f, 1.f}, gb = {1.f, 1.f, 1.f, 1.f};
    if (g) { ga = *(const f32x4*)(g + k0 + 8 * c); gb = *(const f32x4*)(g + k0 + 8 * c + 4); }
    LDS_WAIT(); asm volatile("" ::: "memory");
#pragma unroll
    for (int j = 0; j < 4; ++j) { const int n = (lane >> 3) + 8 * j; const LAS float* sp = scr + (8 * c) * 33 + n;
        v4u o; o.x = pk2(sp[0 * 33] * ga.x, sp[1 * 33] * ga.y); o.y = pk2(sp[2 * 33] * ga.z, sp[3 * 33] * ga.w); o.z = pk2(sp[4 * 33] * gb.x, sp[5 * 33] * gb.y); o.w = pk2(sp[6 * 33] * gb.z, sp[7 * 33] * gb.w);
        *(v4u*)(WT + (size_t)(n0 + n) * K + k0 + 8 * c) = o; }
    LDS_WAIT(); asm volatile("" ::: "memory");
}

namespace pg8 {
struct FlexOrder : StaticOrder {
    int panel, ppm, member;
    __device__ __forceinline__ bool next(int i, Unit& u) const {
        if (panel) { const int pn = member + 4 * i; if (pn >= nN) return false; u.pm = ppm; u.pn = pn; return true; }
        return StaticOrder::next(i, u);
    }
};
}
__device__ __forceinline__ void group_barrier(unsigned* cnt, bool same_l2) {
    asm volatile("s_waitcnt vmcnt(0)" ::: "memory");
    __syncthreads();
    if (threadIdx.x == 0) {
        if (!same_l2) __builtin_amdgcn_fence(__ATOMIC_RELEASE, "agent");
        asm volatile("s_waitcnt vmcnt(0)" ::: "memory");
        __hip_atomic_fetch_add(cnt, 1u, __ATOMIC_RELAXED, __HIP_MEMORY_SCOPE_AGENT);
        unsigned sp = 0u;
        while (__hip_atomic_load(cnt, __ATOMIC_RELAXED, __HIP_MEMORY_SCOPE_AGENT) < 4u) { __builtin_amdgcn_s_sleep(1); if (++sp > (1u << 22)) break; }
        __builtin_amdgcn_fence(__ATOMIC_ACQUIRE, "agent");
        asm volatile("s_waitcnt vmcnt(0)" ::: "memory");
    }
    __syncthreads();
}
#ifndef PROBE_PH
#define PROBE_PH -1
#endif
struct Args { const float* in[17]; float* out; unsigned char* ws; int ph_lo, ph_hi; };

__global__ void __launch_bounds__(NWAVES * 64, 2) yoco_fwd(Args args) {
    extern __shared__ __attribute__((aligned(16))) unsigned char lds[];
    cg::grid_group grid = cg::this_grid();
#define TID_INIT() int tid_ = threadIdx.x; asm volatile("" : "+v"(tid_)); const int tid = tid_, lane = tid & 63, wave = __builtin_amdgcn_readfirstlane(tid >> 6); const int gw = vcu * NWAVES + wave; (void)lane; (void)gw
    const int G = gridDim.x, bx = blockIdx.x;
    for (int u_ = threadIdx.x; u_ < (LDS_BYTES - 131072) / 4; u_ += NWAVES * 64) ((LAS unsigned*)(lds + 131072))[u_] = 0u;
    __syncthreads();
    const XcdBarrier xbar = xcd_barrier_post((unsigned*)(args.ws + WS_CTL) + 4096, (volatile LAS unsigned*)(lds + 131072 + 320) + 8);
    const bool panel_mode = (G == 256);
    const int g_pm = 8 * (bx & 7) + ((bx >> 3) & 7), g_mem = bx >> 6;
    unsigned* const gctl = (unsigned*)(args.ws + WS_CTL + 576 * 1024);
    if (panel_mode && threadIdx.x == 0) __hip_atomic_store(gctl + bx, xb_xcc_id() + 1u, __ATOMIC_RELAXED, __HIP_MEMORY_SCOPE_AGENT);
    bool same_l2 = false;
    const int vcu = (G % 8 == 0) ? (bx % 8) * (G / 8) + bx / 8 : bx;
#define ws (args.ws)
#define x_in (args.in[0])
#define g_mix (args.in[1])
#define g_ffn (args.in[2])
#define w_fin (args.in[3])
#define b_f (args.in[4])
#define w_fout (args.in[5])
#define g_kv (args.in[6])
#define w_kva (args.in[7])
#define g_kva (args.in[8])
#define w_kvb (args.in[9])
#define w_qa (args.in[10])
#define g_qa (args.in[11])
#define w_qb (args.in[12])
#define w_mout (args.in[13])
#define w_up (args.in[14])
#define w_dn (args.in[15])
#define g_fin (args.in[16])
#define out (args.out)
#define ssb ((float*)(ws + WS_CTL))
#define SS(i) (ssb + (size_t)(i) * SS_WORDS)
#define rope ((float*)(ws + WS_ROPE))
#define lf ((float*)(ws + WS_LF))
#define cc ((double*)(ws + WS_C))
#define XB ((bf16*)(ws + WS_XB))
#define FQB ((bf16*)out)
#define FKB ((bf16*)out + (size_t)M * 1024)
#define FVB ((bf16*)(ws + WS_MO))
#define CKVB ((bf16*)out)
#define QAB ((bf16*)out + (size_t)M * 256)
#ifndef STREAM_LO
#define STREAM_LO 0
#endif
#define LOB (STREAM_LO ? (bf16*)out : (bf16*)nullptr)
#define HB ((bf16*)(ws + WS_H))
    const int lo = args.ph_lo, hi_ph = args.ph_hi;
#ifndef PHMASK
#define PHMASK 0xffffffffu
#endif
#define IN(k) (((PHMASK >> (k)) & 1u) && lo <= (k) && (k) < hi_ph)
#define SEAM(k) do { if (IN(k) && IN((k) + 1)) { if (args.ph_lo < 0) grid.sync();   xcd_barrier(xbar); } } while (0)
    const int NGW = G * NWAVES;
#define GSEAM(k) do { if (IN(k) && IN((k) + 1)) { if (panel_mode) group_barrier(gctl + 1024 + ((k) * 64 + g_pm) * 16, same_l2); else xcd_barrier(xbar); } } while (0)
#define FLEX(S, N_) pg8::FlexOrder S; S.init(M, (N_), G, bx); S.panel = panel_mode ? 1 : 0; S.ppm = g_pm; S.member = g_mem

    if (IN(0)) for (int rep_ = 0; rep_ < (PROBE_PH == 0 ? 2 : 1); ++rep_) { TID_INIT();
        LAS float* gwl = (LAS float*)lds;
        for (int i = tid; i < 4 * 1024; i += NWAVES * 64) { const int k = i >> 2, h4 = (i & 3) * 4; const f32x4 w4 = *(const f32x4*)(w_fin + (size_t)k * 3088 + 3072 + h4); const float gk = g_mix[k];
            gwl[(h4 + 0) * 1024 + k] = w4.x * gk; gwl[(h4 + 1) * 1024 + k] = w4.y * gk; gwl[(h4 + 2) * 1024 + k] = w4.z * gk; gwl[(h4 + 3) * 1024 + k] = w4.w * gk; }
        __syncthreads();
        {
            f32x4 v[4], vn[4];
            const int NRW = NGW;
            int m = gw;
            if (m < M) { const f32x4* xr = (const f32x4*)(x_in + (size_t)m * D) + lane;
#pragma unroll
                for (int j = 0; j < 4; ++j) v[j] = xr[64 * j]; }
            for (; m < M; m += NRW) {
                const int mn = m + NRW;
                if (mn < M) { const f32x4* xr = (const f32x4*)(x_in + (size_t)mn * D) + lane;
#pragma unroll
                    for (int j = 0; j < 4; ++j) vn[j] = xr[64 * j]; }
                float s = 0.f;
#pragma unroll
                for (int j = 0; j < 4; ++j) s += (v[j].x * v[j].x + v[j].y * v[j].y) + (v[j].z * v[j].z + v[j].w * v[j].w);
                s = wave_sum(s);
                if (lane == 0) SS(SS0)[m] = s;
                unsigned long long* o8 = (unsigned long long*)(XB + (size_t)m * D) + lane;
#pragma unroll
                for (int j = 0; j < 4; ++j) o8[64 * j] = (unsigned long long)pk2(v[j].x, v[j].y) | ((unsigned long long)pk2(v[j].z, v[j].w) << 32);
                const float rstd = rsqrtf(s * (1.f / D) + RMS_EPS);
                float acc[16];
#pragma unroll
                for (int h = 0; h < 16; ++h) { float d = 0.f;
#pragma unroll
                    for (int j = 0; j < 4; ++j) { const f32x4 w = *(const LAS f32x4*)(gwl + h * 1024 + 256 * j + 4 * lane); d += (v[j].x * w.x + v[j].y * w.y) + (v[j].z * w.z + v[j].w * w.w); }
                    acc[h] = d; if ((h & 3) == 3) asm volatile("" ::: "memory"); }
#pragma unroll
                for (int i = 0; i < 8; ++i) { const bool up = (lane & 32) != 0; const float keep = up ? acc[i + 8] : acc[i], send = up ? acc[i] : acc[i + 8]; acc[i] = keep + __shfl_xor(send, 32); }
#pragma unroll
                for (int i = 0; i < 4; ++i) { const bool up = (lane & 16) != 0; const float keep = up ? acc[i + 4] : acc[i], send = up ? acc[i] : acc[i + 4]; acc[i] = keep + __shfl_xor(send, 16); }
#pragma unroll
                for (int i = 0; i < 2; ++i) { const bool up = (lane & 8) != 0; const float keep = up ? acc[i + 2] : acc[i], send = up ? acc[i] : acc[i + 2]; acc[i] = keep + __shfl_xor(send, 8); }
                { const bool up = (lane & 4) != 0; const float keep = up ? acc[1] : acc[0], send = up ? acc[0] : acc[1]; acc[0] = keep + __shfl_xor(send, 4); }
                acc[0] += __shfl_xor(acc[0], 2); acc[0] += __shfl_xor(acc[0], 1);
                if ((lane & 3) == 0) { const int h = ((lane >> 5) & 1) * 8 + ((lane >> 4) & 1) * 4 + ((lane >> 3) & 1) * 2 + ((lane >> 2) & 1);
                    const float z = acc[0] * rstd + b_f[h]; const float ls = fminf(z, 0.f) - log1pf(expf(-fabsf(z)));
                    lf[(size_t)((m >> 13) * 16 + h) * SEQ + (m & (SEQ - 1))] = ls; }
#pragma unroll
                for (int j = 0; j < 4; ++j) v[j] = vn[j];
            }
        }
        for (int idx = bx * (NWAVES * 64) + tid; idx < SEQ * 32; idx += G * NWAVES * 64) { const int pos = idx >> 5, i = idx & 31;
            const float inv = exp2f(-(float)i * (13.287712379549449f / 32.f)); const float ang = (float)pos * inv;
            double rv = (double)ang * 0.15915494309189535; rv -= __builtin_rint(rv); const float fr = (float)rv;
            rope[2 * idx] = __builtin_amdgcn_cosf(fr); rope[2 * idx + 1] = __builtin_amdgcn_sinf(fr); }
        __syncthreads();
        LAS float* scr = (LAS float*)(lds + wave * 16384);
        constexpr int I0 = 16 * 96, I1 = 16 * 32, I2 = 16 * 24, I3 = 4 * 64, I4 = 6 * 48, I5 = 16 * 32, I6 = 16 * 128, I8 = 64 * 32;
        constexpr int NIT = I0 + I1 + I2 + I3 + I4 + I5 + 2 * I6 + 2 * I8;
        for (int it = gw; it < NIT; it += NGW) { int r = it; const int nl = lane & 31;
#define TR_PLAIN(Wp, ldw_, gp, K_, nblk_, dst_) do { const int k0_ = 64 * (r / (nblk_)), n0_ = 32 * (r % (nblk_)); tr_item2((Wp), (ldw_), n0_ + nl, (gp), (K_), k0_, n0_, (bf16*)(ws + (dst_)), scr, lane); } while (0)
            if (r < I0) { TR_PLAIN(w_fin, 3088, g_mix, 1024, 96, W_FIN); continue; } r -= I0;
            if (r < I1) { TR_PLAIN(w_fout, 1024, nullptr, 1024, 32, W_FOUT); continue; } r -= I1;
            if (r < I2) { const int k0_ = 64 * (r / 24), n0_ = 32 * (r % 24), n_ = n0_ + nl;
                if (n0_ < 256) tr_item2(w_kva, 320, n_, g_kv, 1024, k0_, n0_, (bf16*)(ws + W_QKVA), scr, lane);
                else if (n0_ < 640) tr_item2(w_qa, 384, n_ - 256, g_mix + D, 1024, k0_, n0_, (bf16*)(ws + W_QKVA), scr, lane);
                else if (n0_ < 704) { const int c2 = n_ - 640; tr_item2(w_kva, 320, 256 + (c2 >> 1) + 32 * (c2 & 1), g_kv, 1024, k0_, n0_, (bf16*)(ws + W_QKVA), scr, lane); }
                else tr_item2(w_kva, 320, -1, nullptr, 1024, k0_, n0_, (bf16*)(ws + W_QKVA), scr, lane);
                continue; } r -= I2;
            if (r < I3) { TR_PLAIN(w_kvb, 2048, g_kva, 256, 64, W_KVB); continue; } r -= I3;
            if (r < I4) { const int k0_ = 64 * (r / 48), n0_ = 32 * (r % 48), n_ = n0_ + nl; int src;
                if (n_ < 1024) src = (n_ >> 7) * 192 + (n_ & 127); else { const int q_ = n_ - 1024; src = (q_ >> 6) * 192 + 128 + ((q_ & 63) >> 1) + 32 * (q_ & 1); }
                tr_item2(w_qb, 1536, src, g_qa, 384, k0_, n0_, (bf16*)(ws + W_QB), scr, lane); continue; } r -= I4;
            if (r < I5) { if (!panel_mode) TR_PLAIN(w_mout, 1024, nullptr, 1024, 32, W_MOUT); continue; } r -= I5;
            if (r < I6) { TR_PLAIN(w_up, 4096, g_ffn, 1024, 128, W_UP0); continue; } r -= I6;
            if (r < I6) { if (!panel_mode) TR_PLAIN(w_up + (size_t)D * FF, 4096, g_ffn + D, 1024, 128, W_UP1); continue; } r -= I6;
            if (r < I8) { TR_PLAIN(w_dn, 1024, nullptr, 4096, 32, W_DN0); continue; } r -= I8;
            if (!panel_mode) TR_PLAIN(w_dn + (size_t)FF * D, 1024, nullptr, 4096, 32, W_DN1);
        }
        __syncthreads();
    }
    SEAM(0);
    if (IN(1)) for (int rep_ = 0; rep_ < (PROBE_PH == 1 ? 2 : 1); ++rep_) { TID_INIT();
        LAS double* red = (LAS double*)lds;
        for (int w = bx; w < 256; w += G) { const int bh = w >> 3, ch = w & 7; const float* src = lf + (size_t)bh * SEQ;
            double p = 0.0; { float pv_[14];
#pragma unroll
                for (int k = 0; k < 14; ++k) { const int i = tid + k * (NWAVES * 64); pv_[k] = i < ch * 1024 ? src[i] : 0.f; }
#pragma unroll
                for (int k = 0; k < 14; ++k) p += (double)pv_[k]; }
            p = wave_sum_d(p); if (lane == 0) red[wave] = p;
            __syncthreads();
            double pre = 0.0;
#pragma unroll
            for (int k = 0; k < 8; ++k) pre += red[k];
            const float a = src[ch * 1024 + 2 * tid], b = src[ch * 1024 + 2 * tid + 1]; const double s2 = (double)a + (double)b;
            double inc = s2;
#pragma unroll
            for (int o = 1; o < 64; o <<= 1) { const int thi = __shfl_up(__double2hiint(inc), o), tlo = __shfl_up(__double2loint(inc), o); if (lane >= o) inc += __hiloint2double(thi, tlo); }
            if (lane == 63) red[8 + wave] = inc;
            __syncthreads();
            double woff = 0.0;
#pragma unroll
            for (int k = 0; k < 8; ++k) if (k < wave) woff += red[8 + k];
            const double excl = pre + woff + inc - s2;
            cc[(size_t)bh * SEQ + ch * 1024 + 2 * tid] = excl + (double)a; cc[(size_t)bh * SEQ + ch * 1024 + 2 * tid + 1] = excl + s2;
            __syncthreads();
        }
        pg8::Gemm g{XB, (const bf16*)(ws + W_FIN), M, 3072, 1024}; pg8::StaticOrder S; S.init(M, 3072, G, bx);
        pg8::EpiQKV E{FQB, (size_t)M * 1024, FVB, SS(SS0), C2_FOX, (unsigned*)(ws + WS_CTL + 512 * 1024)};
        pg8::gemm_phase<pg8::EpiQKV, pg8::StaticOrder, true, true>((LAS unsigned char*)lds, g, S, E);
    }
    SEAM(1);
    if (panel_mode) {
        if (threadIdx.x == 0) { const unsigned mine = __hip_atomic_load(gctl + bx, __ATOMIC_RELAXED, __HIP_MEMORY_SCOPE_AGENT); unsigned same = 1u;
#pragma unroll
            for (int m_ = 0; m_ < 4; ++m_) same &= (__hip_atomic_load(gctl + 8 * ((g_pm & 7) + 8 * m_) + (g_pm >> 3), __ATOMIC_RELAXED, __HIP_MEMORY_SCOPE_AGENT) == mine) ? 1u : 0u;
            ((LAS unsigned*)(lds + 131072))[16] = same; }
        __syncthreads();
        same_l2 = ((LAS unsigned*)(lds + 131072))[16] != 0u;
    }
    if (IN(2)) {
        for (int i = 0, idx = vcu; panel_mode ? i < 4 : idx < 1024; ++i, idx += G) { int bh, qb;
            if (panel_mode) { bh = (g_pm >> 5) * 16 + 4 * g_mem + i; qb = g_pm & 31; }
            else { const int k4 = idx >> 8, v = idx & 255, s_ = v & 7; bh = v >> 3; qb = (k4 == 0) ? s_ : (k4 == 1) ? 15 - s_ : (k4 == 2) ? 16 + s_ : 31 - s_; }
            const int b = bh >> 4, h = bh & 15;
            att::Unit U; const size_t ro = (size_t)b * SEQ * 1024 + h * 64;
            U.q[0] = FQB + ro; U.q[1] = U.q[0]; U.qs = 1024;
            U.kA = FKB + ro; U.ksA = 1024; U.kB = U.kA; U.ksB = 1024;
            U.v = FVB + ro; U.vs = 1024;
            U.o = FQB + ro; U.os = 1024; U.c = cc + (size_t)bh * SEQ; U.rtab = nullptr; U.kmax2 = (const unsigned*)(ws + WS_CTL + 512 * 1024) + bh * 2; U.q0 = qb * 256; U.j_lo = 0;
            att::attn_unit<64, 64, true>(U, (char*)lds);
        }
    }
    GSEAM(2);
    if (IN(3)) {
        pg8::Gemm g{FQB, (const bf16*)(ws + W_FOUT), M, 1024, 1024}; FLEX(S, 1024);
        pg8::EpiRes E{STREAM_LO ? x_in : (const float*)nullptr, XB, LOB, SS(SS1)};
        pg8::gemm_phase<pg8::EpiRes, pg8::FlexOrder, true, true>((LAS unsigned char*)lds, g, S, E);
    }
    GSEAM(3);
    if (IN(4)) for (int rep_ = 0; rep_ < (PROBE_PH == 4 ? 2 : 1); ++rep_) {
        pg8::Gemm g{XB, (const bf16*)(ws + W_UP0), M, 4096, 1024}; FLEX(S, 4096);
        pg8::EpiUp E{HB, SS(SS1)};
        pg8::gemm_phase<pg8::EpiUp, pg8::FlexOrder, true, true>((LAS unsigned char*)lds, g, S, E);
    }
    GSEAM(4);
    if (IN(5)) {
        pg8::Gemm g{HB, (const bf16*)(ws + W_DN0), M, 1024, 4096}; FLEX(S, 1024);
        pg8::EpiRes E{nullptr, XB, LOB, SS(SS2)};
        pg8::gemm_phase<pg8::EpiRes, pg8::FlexOrder, true, true>((LAS unsigned char*)lds, g, S, E);
    }
    GSEAM(5);
    if (IN(6) && panel_mode) {
        if (threadIdx.x == 0) { const int dep[3] = {g_pm >> 2, (4096 + 96 * g_pm) >> 8, (4096 + 96 * g_pm + 95) >> 8};
#pragma unroll
            for (int d_ = 0; d_ < 3; ++d_) { const unsigned* c_ = gctl + 1024 + (3 * 64 + dep[d_]) * 16; unsigned sp = 0u;
                while (__hip_atomic_load(c_, __ATOMIC_RELAXED, __HIP_MEMORY_SCOPE_AGENT) < 4u) { __builtin_amdgcn_s_sleep(1); if (++sp > (1u << 22)) break; } } }
        __syncthreads();
    }
    if (IN(6)) {
        if (panel_mode && g_mem == 3) { TID_INIT();
            LAS float* scr = (LAS float*)(lds + wave * 16384); const int nl = lane & 31;
            for (int it = g_pm * NWAVES + wave; it < 512 + 2048 + 2048; it += 64 * NWAVES) { int r = it;
                if (r < 512) { TR_PLAIN(w_mout, 1024, nullptr, 1024, 32, W_MOUT); continue; } r -= 512;
                if (r < 2048) { TR_PLAIN(w_up + (size_t)D * FF, 4096, g_ffn + D, 1024, 128, W_UP1); continue; } r -= 2048;
                TR_PLAIN(w_dn + (size_t)FF * D, 1024, nullptr, 4096, 32, W_DN1); }
            __syncthreads();
        }
        pg8::Gemm g{XB, (const bf16*)(ws + W_QKVA), M, 768, 1024}; FLEX(S, 768);
        pg8::EpiQKVA E{CKVB, QAB, (bf16*)(ws + WS_MKR), SS(SS2), SS(SSKV), SS(SSQ), rope};
        pg8::gemm_phase<pg8::EpiQKVA, pg8::FlexOrder, true, true>((LAS unsigned char*)lds, g, S, E);
    }
    GSEAM(6);
    if (IN(7) && panel_mode) {
        if (threadIdx.x == 0) { const int dep[3] = {g_pm >> 1, (256 + 3 * g_pm) >> 3, (258 + 3 * g_pm) >> 3};
#pragma unroll
            for (int d_ = 0; d_ < 3; ++d_) { const unsigned* c_ = gctl + 1024 + (5 * 64 + dep[d_]) * 16; unsigned sp = 0u;
                while (__hip_atomic_load(c_, __ATOMIC_RELAXED, __HIP_MEMORY_SCOPE_AGENT) < 4u) { __builtin_amdgcn_s_sleep(1); if (++sp > (1u << 22)) break; } } }
        __syncthreads();
    }
    if (IN(7)) for (int rep_ = 0; rep_ < (PROBE_PH == 7 ? 2 : 1); ++rep_) {
        { pg8::Gemm g{CKVB, (const bf16*)(ws + W_KVB), M, 2048, 256}; FLEX(S, 2048);
          pg8::EpiKVB E{(bf16*)(ws + WS_MKV), SS(SSKV)};
          pg8::gemm_phase<pg8::EpiKVB, pg8::FlexOrder, true, true>((LAS unsigned char*)lds, g, S, E); }
        { pg8::Gemm g{QAB, (const bf16*)(ws + W_QB), M, 1536, 384}; FLEX(S, 1536);
          pg8::EpiQB E{(bf16*)(ws + WS_MQ), SS(SSQ), C2_MLA};
          pg8::gemm_phase<pg8::EpiQB, pg8::FlexOrder, false, true>((LAS unsigned char*)lds, g, S, E); }
    }
    SEAM(7);
    if (IN(8)) for (int rep_ = 0; rep_ < (PROBE_PH == 8 ? 2 : 1); ++rep_) {
        for (int i = vcu; i < 512; i += G) { const int k2 = i >> 8, v = i & 255, bh = v >> 4, s = v & 15, b = bh >> 3, h = bh & 7;
            const int qb = (k2 == 0) ? 31 - s : s;
            att::Unit U; const size_t rq = (size_t)b * SEQ * 1536, rk = (size_t)b * SEQ * 2048;
            U.q[0] = (const bf16*)(ws + WS_MQ) + rq + h * 128; U.q[1] = (const bf16*)(ws + WS_MQ) + rq + 1024 + h * 64; U.qs = 1536;
            U.kA = (const bf16*)(ws + WS_MKV) + rk + h * 256; U.ksA = 2048; U.kB = (const bf16*)(ws + WS_MKR) + (size_t)b * SEQ * 64; U.ksB = 64;
            U.v = (const bf16*)(ws + WS_MKV) + rk + h * 256 + 128; U.vs = 2048;
            U.o = (bf16*)(ws + WS_MO) + (size_t)b * SEQ * 1024 + h * 128; U.os = 1024; U.c = nullptr; U.kmax2 = nullptr; U.rtab = rope; U.q0 = qb * 256; U.j_lo = 0;
            att::attn_unit<192, 128, false>(U, (char*)lds);
        }
    }
    SEAM(8);
    if (IN(9)) {
        pg8::Gemm g{(const bf16*)(ws + WS_MO), (const bf16*)(ws + W_MOUT), M, 1024, 1024}; FLEX(S, 1024);
        pg8::EpiRes E{nullptr, XB, LOB, SS(SS3)};
        pg8::gemm_phase<pg8::EpiRes, pg8::FlexOrder, true, true>((LAS unsigned char*)lds, g, S, E);
    }
    GSEAM(9);
    if (IN(10)) {
        pg8::Gemm g{XB, (const bf16*)(ws + W_UP1), M, 4096, 1024}; FLEX(S, 4096);
        pg8::EpiUp E{HB, SS(SS3)};
        pg8::gemm_phase<pg8::EpiUp, pg8::FlexOrder, true, true>((LAS unsigned char*)lds, g, S, E);
    }
    GSEAM(10);
    if (IN(11)) {
        pg8::Gemm g{HB, (const bf16*)(ws + W_DN1), M, 1024, 4096}; FLEX(S, 1024);
        if (G == 256) {
            pg8::EpiResFinal E{XB, LOB, out, SS(SS4), g_fin, (unsigned*)(ws + WS_CTL + 40960)};
            pg8::gemm_phase<pg8::EpiResFinal, pg8::FlexOrder, false, true>((LAS unsigned char*)lds, g, S, E);
        } else {
            pg8::EpiRes E{nullptr, XB, LOB, SS(SS4)};
            pg8::gemm_phase<pg8::EpiRes, pg8::FlexOrder, true, true>((LAS unsigned char*)lds, g, S, E);
            xcd_barrier(xbar);
            TID_INIT();
            if (wave == 0) for (int pm_ = bx; pm_ < M / 256; pm_ += G) for (int rr = 255; rr >= 0; --rr) { const int m = pm_ * 256 + rr;
                const float rstd = rsqrtf(SS(SS4)[m] * (1.f / D) + RMS_EPS); f32x4 v[4];
#pragma unroll
                for (int j = 0; j < 4; ++j) { const size_t e = (size_t)m * D + 256 * j + 4 * lane; const unsigned long long hw = *(const unsigned long long*)(XB + e), lw = STREAM_LO ? *(const unsigned long long*)((const bf16*)out + (size_t)pm_ * 262144 + e) : 0ull;
                    v[j].x = __uint_as_float((unsigned)hw << 16) + __uint_as_float((unsigned)lw << 16); v[j].y = __uint_as_float((unsigned)hw & 0xffff0000u) + __uint_as_float((unsigned)lw & 0xffff0000u);
                    v[j].z = __uint_as_float((unsigned)(hw >> 32) << 16) + __uint_as_float((unsigned)(lw >> 32) << 16); v[j].w = __uint_as_float((unsigned)(hw >> 32) & 0xffff0000u) + __uint_as_float((unsigned)(lw >> 32) & 0xffff0000u); }
                asm volatile("s_waitcnt vmcnt(0)" ::: "memory");
#pragma unroll
                for (int j = 0; j < 4; ++j) *((f32x4*)(out + (size_t)m * D) + 64 * j + lane) = v[j] * rstd * *((const f32x4*)g_fin + 64 * j + lane);
                asm volatile("s_waitcnt vmcnt(0)" ::: "memory"); }
        }
    }
#undef TR_PLAIN
#undef IN
#undef SEAM
#undef GSEAM
#undef FLEX
#undef SS
#undef x_in
#undef g_mix
#undef g_ffn
#undef w_fin
#undef b_f
#undef w_fout
#undef g_kv
#undef w_kva
#undef g_kva
#undef w_kvb
#undef w_qa
#undef g_qa
#undef w_qb
#undef w_mout
#undef w_up
#undef w_dn
#undef g_fin
#undef out
#undef ws
#undef rope
#undef lf
#undef cc
#undef XB
#undef FQB
#undef FKB
#undef FVB
#undef CKVB
#undef QAB
#undef LOB
#undef HB
#undef ssb
}

constexpr int N_PHASES = 12;
#ifndef MK_PER_PHASE
#define MK_PER_PHASE 0
#endif
extern "C" void kernel_launch(void* const* d_in, const int* in_sizes, int n_in, void* d_out, int out_size, void* d_ws, size_t ws_size, hipStream_t stream) {
    static int grid = 0;
    if (grid == 0) {
        if (n_in != 17 || in_sizes[0] != M * D || out_size != M * D || ws_size < WS_END) { fprintf(stderr, "kernel_launch: unexpected shapes (n_in %d, in0 %d, out %d, ws %zu)\n", n_in, n_in > 0 ? in_sizes[0] : -1, out_size, ws_size); grid = -1; return; }
        int dev = 0, cus = 0, per_cu = 0;
        if (hipGetDevice(&dev) != hipSuccess || hipDeviceGetAttribute(&cus, hipDeviceAttributeMultiprocessorCount, dev) != hipSuccess) { grid = -1; return; }
        if (hipFuncSetAttribute((const void*)yoco_fwd, hipFuncAttributeMaxDynamicSharedMemorySize, LDS_BYTES) != hipSuccess) { fprintf(stderr, "kernel_launch: hipFuncSetAttribute failed\n"); grid = -1; return; }
        if (hipOccupancyMaxActiveBlocksPerMultiprocessor(&per_cu, (const void*)yoco_fwd, NWAVES * 64, LDS_BYTES) != hipSuccess || per_cu < 1) { fprintf(stderr, "kernel_launch: occupancy query says %d\n", per_cu); per_cu = 1; }
        (void)hipGetLastError();
        grid = cus * per_cu;
    }
    if (grid < 0) return;
    (void)hipMemsetAsync((char*)d_ws + WS_CTL, 0, CTL_ZERO_BYTES, stream);
    Args a{};
    for (int i = 0; i < 17; ++i) a.in[i] = (const float*)d_in[i];
    a.out = (float*)d_out; a.ws = (unsigned char*)d_ws;
#if MK_PER_PHASE
    for (int p = 0; p < N_PHASES; ++p) { a.ph_lo = p; a.ph_hi = p + 1; hipLaunchKernelGGL(yoco_fwd, dim3(grid), dim3(NWAVES * 64), LDS_BYTES, stream, a); }
#else
    a.ph_lo = 0; a.ph_hi = N_PHASES;
    void* kargs[] = {&a};
    hipError_t e = hipLaunchCooperativeKernel((const void*)yoco_fwd, dim3(grid), dim3(NWAVES * 64), kargs, LDS_BYTES, stream);
    if (e != hipSuccess) fprintf(stderr, "kernel_launch: cooperative launch failed: %s (grid %d)\n", hipGetErrorString(e), grid);
#endif
}
```

```cpp
#include <hip/hip_runtime.h>
#include <hip/hip_cooperative_groups.h>
#include <cstdio>
#include <cstdint>
namespace cg = cooperative_groups;
namespace pg8 {
#define PG8_LAS __attribute__((address_space(3)))
typedef unsigned short bf16_t;
typedef short bf16x8 __attribute__((ext_vector_type(8)));
typedef float f32x4 __attribute__((ext_vector_type(4)));
typedef unsigned u32x4 __attribute__((ext_vector_type(4)));
constexpr int BM = 256, BK = 64, HALF = 128, HTB = HALF * BK * 2  , STAGE_BYTES = 8 * HTB, NXCD = 8, WGM = 8;

__host__ __device__ __forceinline__ int lds_byte(int r, int c) { const int st = (r >> 4) * 2 + (c >> 5), rr = r & 15, cc = c & 31, ob = rr * 64 + cc * 2; return st * 1024 + (ob ^ (((ob >> 9) & 1) << 5)); }
__host__ __device__ __forceinline__ void stage_rc(int b, int& R, int& C) { const int st = b / 1024, sb = b % 1024, swz = sb ^ (((sb >> 9) & 1) << 5); R = (st >> 1) * 16 + swz / 64; C = (st & 1) * 32 + (swz % 64) / 2; }
__host__ __device__ __forceinline__ int perm32(int rho) { const int n = rho >> 4, i = rho & 15; return 8 * (i >> 2) + 4 * n + (i & 3); }

struct Unit { int pm, pn; };
struct Gemm { const bf16_t* A; const bf16_t* Bt; int M, N, K; };

struct StaticOrder {
    int nM, nN, nwg, G, c;
    __host__ __device__ void init(int M, int N, int G_, int c_) { nM = M / BM; nN = N / BM; nwg = nM * nN; G = G_; c = c_; }
    __host__ __device__ bool next(int i, Unit& u) const {
        const long L = (long)i * G + c; if (L >= nwg) return false;
        int wgid = (int)L; { const int q = nwg / NXCD, r = nwg % NXCD, xcd = wgid % NXCD, off = wgid / NXCD; wgid = (xcd < r ? xcd * (q + 1) : r * (q + 1) + (xcd - r) * q) + off; }
        const int nig = WGM * nN, gid = wgid / nig, fm = gid * WGM, gsz = (nM - fm) < WGM ? (nM - fm) : WGM;
        u.pm = fm + ((wgid % nig) % gsz); u.pn = (wgid % nig) / gsz; return true;
    }
    __device__ __forceinline__ void a_ready(const Unit&) const {}
    __device__ __forceinline__ void done(const Unit&) const {}
};

__device__ __forceinline__ unsigned cvt_pk_bf16(float lo, float hi) { unsigned r; asm volatile("v_cvt_pk_bf16_f32 %0, %1, %2" : "=v"(r) : "v"(lo), "v"(hi)); return r; }
typedef float f32x2 __attribute__((ext_vector_type(2)));
template <class Epi, class Sched, bool ALIGN_EPI = false, bool SP2 = false>
__device__ __forceinline__ void gemm_phase(PG8_LAS unsigned char* lds, const Gemm g, const Sched& S, const Epi& E) {
    int tid_ = threadIdx.x; asm volatile("" : "+v"(tid_));
    const int tid = tid_, wid = __builtin_amdgcn_readfirstlane(tid >> 6), lane = tid & 63, wr = wid >> 2, wc = wid & 3, fr = lane & 15, fq = lane >> 4;
    const int K = g.K, nt = K / BK;
    unsigned voffA[2], voffB[2];
#pragma unroll
    for (int i = 0; i < 2; ++i) { int R, C; stage_rc(tid * 16 + i * 8192, R, C); const int Rb = Epi::PERM ? ((R & ~31) + perm32(R & 31)) : R;
        voffA[i] = (unsigned)(R * K + C) * 2u; voffB[i] = (unsigned)(Rb * K + C) * 2u; }
    const size_t kstep = (size_t)(BK * 2);
    const size_t hstep = (size_t)HALF * K * 2;
    const size_t tstep = 2 * hstep;
    const unsigned ldsw = (unsigned)wid * 1024u;
    const int aoff = lds_byte(wr * 64 + fr, fq * 8), boff = lds_byte(wc * 32 + fr, fq * 8);
#define PG8_SA(b, h) (((b) * 2 + (h)) * HTB)
#define PG8_SB(b, h) ((4 + (b) * 2 + (h)) * HTB)
#define PG8_STAGE(bufoff, gbase, voff) do { _Pragma("unroll") for (int _i = 0; _i < 2; ++_i) \
        __builtin_amdgcn_global_load_lds((const unsigned*)((const char*)(gbase) + (voff)[_i]), (PG8_LAS unsigned*)(lds + (bufoff) + ldsw + _i * 8192), 16, 0, 0); } while (0)
#define PG8_LDA(dst, b, h) do { _Pragma("unroll") for (int m = 0; m < 4; ++m) _Pragma("unroll") for (int k = 0; k < 2; ++k) dst[m][k] = *(const PG8_LAS bf16x8*)(lds + PG8_SA(b, h) + aoff + m * 2048 + k * 1024); } while (0)
#define PG8_LDB(dst, b, h) do { _Pragma("unroll") for (int n = 0; n < 2; ++n) _Pragma("unroll") for (int k = 0; k < 2; ++k) dst[n][k] = *(const PG8_LAS bf16x8*)(lds + PG8_SB(b, h) + boff + n * 2048 + k * 1024); } while (0)
#define PG8_MMA(ai, bj, At, Bt) do { __builtin_amdgcn_s_setprio(1); _Pragma("unroll") for (int m = 0; m < 4; ++m) _Pragma("unroll") for (int n = 0; n < 2; ++n) _Pragma("unroll") for (int k = 0; k < 2; ++k) \
        acc[ai][bj][m][n] = __builtin_amdgcn_mfma_f32_16x16x32_bf16(Bt[n][k], At[m][k], acc[ai][bj][m][n], 0, 0, 0); __builtin_amdgcn_s_setprio(0); } while (0)
#define PG8_WAIT_V(n) asm volatile("s_waitcnt vmcnt(" #n ")" ::: "memory")
#define PG8_WAIT_L(n) asm volatile("s_waitcnt lgkmcnt(" #n ")" ::: "memory")
#define PG8_BAR __builtin_amdgcn_s_barrier()
#define PG8_SCHED __builtin_amdgcn_sched_barrier(0)
    Unit cur, nxt; int ui = 0;
    if (!S.next(0, cur)) return;
    f32x4 acc[2][2][4][2];
#pragma unroll
    for (int a = 0; a < 2; ++a)
#pragma unroll
        for (int b = 0; b < 2; ++b)
#pragma unroll
            for (int m = 0; m < 4; ++m)
#pragma unroll
                for (int n = 0; n < 2; ++n) acc[a][b][m][n] = (f32x4){0.f, 0.f, 0.f, 0.f};
    bf16x8 At[4][2], B0[2][2], B1[2][2];
    const char* cA = (const char*)g.A + (size_t)cur.pm * tstep; const char* cB = (const char*)g.Bt + (size_t)cur.pn * tstep;
    S.a_ready(cur);
    if constexpr (SP2) {
        PG8_STAGE(PG8_SB(0, 0), cB, voffB); PG8_STAGE(PG8_SB(0, 1), cB + hstep, voffB); PG8_STAGE(PG8_SA(0, 0), cA, voffA); PG8_STAGE(PG8_SA(0, 1), cA + hstep, voffA);
        if (wr == 1) PG8_BAR;
        PG8_WAIT_V(2); PG8_BAR;
        PG8_STAGE(PG8_SB(1, 0), cB + kstep, voffB); PG8_STAGE(PG8_SA(1, 0), cA + kstep, voffA); PG8_STAGE(PG8_SB(1, 1), cB + hstep + kstep, voffB);
        PG8_WAIT_V(6); PG8_BAR;
    } else {
        PG8_STAGE(PG8_SB(0, 0), cB, voffB); PG8_STAGE(PG8_SA(0, 0), cA, voffA); PG8_STAGE(PG8_SB(0, 1), cB + hstep, voffB); PG8_STAGE(PG8_SA(0, 1), cA + hstep, voffA);
        if (wr == 1) PG8_BAR;
        PG8_WAIT_V(4); PG8_BAR;
        PG8_STAGE(PG8_SB(1, 0), cB + kstep, voffB); PG8_STAGE(PG8_SA(1, 0), cA + kstep, voffA); PG8_STAGE(PG8_SB(1, 1), cB + hstep + kstep, voffB);
        PG8_WAIT_V(6); PG8_BAR;
    }
    for (;;) {
        const bool has_next = S.next(ui + 1, nxt);
        const char* nA = has_next ? (const char*)g.A + (size_t)nxt.pm * tstep : cA; const char* nB = has_next ? (const char*)g.Bt + (size_t)nxt.pn * tstep : cB;
#pragma unroll 1
        for (int t = 0; t < nt; t += 2) {
            const bool last = (t == nt - 2);
            const char* a1 = cA + (size_t)(t + 1) * kstep;
            const char* a2 = last ? nA : cA + (size_t)(t + 2) * kstep; const char* b2 = last ? nB : cB + (size_t)(t + 2) * kstep;
            const char* a3 = a2 + kstep; const char* b3 = b2 + kstep;
            if (last && has_next) S.a_ready(nxt);
            if constexpr (SP2) {
            PG8_LDB(B0, 0, 0); PG8_LDB(B1, 0, 1); PG8_SCHED; PG8_LDA(At, 0, 0); PG8_STAGE(PG8_SA(1, 1), a1 + hstep, voffA);
            PG8_WAIT_V(8); PG8_WAIT_L(0); PG8_BAR; PG8_MMA(0, 0, At, B0); PG8_MMA(0, 1, At, B1); PG8_BAR; PG8_SCHED;
            PG8_LDA(At, 0, 1); PG8_STAGE(PG8_SB(0, 0), b2, voffB); PG8_STAGE(PG8_SB(0, 1), b2 + hstep, voffB); PG8_STAGE(PG8_SA(0, 0), a2, voffA);
            PG8_WAIT_V(8); PG8_WAIT_L(0); PG8_BAR; PG8_MMA(1, 0, At, B0); PG8_MMA(1, 1, At, B1); PG8_BAR; PG8_SCHED;
            PG8_LDB(B0, 1, 0); PG8_LDB(B1, 1, 1); PG8_SCHED; PG8_LDA(At, 1, 0); PG8_STAGE(PG8_SA(0, 1), a2 + hstep, voffA);
            PG8_WAIT_V(8); PG8_WAIT_L(0); PG8_BAR; PG8_MMA(0, 0, At, B0); PG8_MMA(0, 1, At, B1); PG8_BAR; PG8_SCHED;
            PG8_LDA(At, 1, 1); PG8_STAGE(PG8_SB(1, 0), b3, voffB); PG8_STAGE(PG8_SB(1, 1), b3 + hstep, voffB); PG8_STAGE(PG8_SA(1, 0), a3, voffA);
            PG8_WAIT_V(8); PG8_WAIT_L(0); PG8_BAR; PG8_MMA(1, 0, At, B0); PG8_MMA(1, 1, At, B1); PG8_BAR; PG8_SCHED;
            } else {
            PG8_LDB(B0, 0, 0); PG8_SCHED; PG8_LDA(At, 0, 0); PG8_STAGE(PG8_SA(1, 1), a1 + hstep, voffA);
            PG8_WAIT_L(8); PG8_BAR; PG8_WAIT_L(0); PG8_MMA(0, 0, At, B0); PG8_BAR; PG8_SCHED;
            PG8_LDB(B1, 0, 1); PG8_STAGE(PG8_SB(0, 0), b2, voffB);
            PG8_BAR; PG8_WAIT_L(0); PG8_MMA(0, 1, At, B1); PG8_BAR;
            PG8_LDA(At, 0, 1); PG8_STAGE(PG8_SA(0, 0), a2, voffA);
            PG8_BAR; PG8_WAIT_L(0); PG8_MMA(1, 0, At, B0); PG8_BAR; PG8_SCHED;
            PG8_STAGE(PG8_SB(0, 1), b2 + hstep, voffB);
            PG8_WAIT_V(6); PG8_BAR; PG8_MMA(1, 1, At, B1); PG8_BAR;
            PG8_LDB(B0, 1, 0); PG8_SCHED; PG8_LDA(At, 1, 0); PG8_STAGE(PG8_SA(0, 1), a2 + hstep, voffA);
            PG8_WAIT_L(8); PG8_BAR; PG8_WAIT_L(0); PG8_MMA(0, 0, At, B0); PG8_BAR; PG8_SCHED;
            PG8_LDB(B1, 1, 1); PG8_STAGE(PG8_SB(1, 0), b3, voffB);
            PG8_BAR; PG8_WAIT_L(0); PG8_MMA(0, 1, At, B1); PG8_BAR;
            PG8_LDA(At, 1, 1); PG8_STAGE(PG8_SA(1, 0), a3, voffA);
            PG8_BAR; PG8_WAIT_L(0); PG8_MMA(1, 0, At, B0); PG8_BAR; PG8_SCHED;
            PG8_STAGE(PG8_SB(1, 1), b3 + hstep, voffB);
            PG8_WAIT_V(6); PG8_BAR; PG8_MMA(1, 1, At, B1); PG8_BAR;
            }
        }
        if constexpr (ALIGN_EPI) { if (wr == 0) PG8_BAR; }
        if constexpr (!Epi::AFTER_DRAIN) { E(acc, cur, wr, wc, fr, fq); S.done(cur); }
        if (!has_next) break;
#pragma unroll
        for (int a = 0; a < 2; ++a)
#pragma unroll
            for (int b = 0; b < 2; ++b)
#pragma unroll
                for (int m = 0; m < 4; ++m)
#pragma unroll
                    for (int n = 0; n < 2; ++n) acc[a][b][m][n] = (f32x4){0.f, 0.f, 0.f, 0.f};
        cur = nxt; cA = nA; cB = nB; ++ui;
        if constexpr (ALIGN_EPI) { if (wr == 1) PG8_BAR; }
    }
    PG8_WAIT_V(0);
    if constexpr (!ALIGN_EPI) { if (wr == 0) PG8_BAR; }
    PG8_BAR;
    if constexpr (Epi::AFTER_DRAIN) { E.fused(acc, cur, wr, wc, fr, fq, lds, wid, lane); S.done(cur); }
#undef PG8_SA
#undef PG8_SB
#undef PG8_STAGE
#undef PG8_LDA
#undef PG8_LDB
#undef PG8_MMA
#undef PG8_WAIT_V
#undef PG8_WAIT_L
#undef PG8_BAR
#undef PG8_SCHED
}
}
namespace pg8 {
typedef unsigned u32x2 __attribute__((ext_vector_type(2)));
constexpr float RMS_EPS = 1e-6f;
__device__ __forceinline__ u32x4 pack8(f32x4 a, f32x4 b) { u32x4 w; w.x = cvt_pk_bf16(a[0], a[1]); w.y = cvt_pk_bf16(a[2], a[3]); w.z = cvt_pk_bf16(b[0], b[1]); w.w = cvt_pk_bf16(b[2], b[3]); return w; }
__device__ __forceinline__ float sumsq8(f32x4 a, f32x4 b) { return (a[0] * a[0] + a[1] * a[1]) + (a[2] * a[2] + a[3] * a[3]) + (b[0] * b[0] + b[1] * b[1]) + (b[2] * b[2] + b[3] * b[3]); }
__device__ __forceinline__ void rope8(f32x4& v0, f32x4& v1, const float* tab) {
    const f32x4 t0 = *(const f32x4*)tab, t1 = *(const f32x4*)(tab + 4);
    f32x4 a, b;
    a[0] = v0[0] * t0[0] - v0[1] * t0[1]; a[1] = v0[1] * t0[0] + v0[0] * t0[1];
    a[2] = v0[2] * t0[2] - v0[3] * t0[3]; a[3] = v0[3] * t0[2] + v0[2] * t0[3];
    b[0] = v1[0] * t1[0] - v1[1] * t1[1]; b[1] = v1[1] * t1[0] + v1[0] * t1[1];
    b[2] = v1[2] * t1[2] - v1[3] * t1[3]; b[3] = v1[3] * t1[2] + v1[2] * t1[3];
    v0 = a; v1 = b;
}
__device__ __forceinline__ void row_rstd(float (&rs)[2][4], const float* ss, int row0, float invn, float mul) {
    float t[2][4];
#pragma unroll
    for (int ai = 0; ai < 2; ++ai)
#pragma unroll
        for (int m = 0; m < 4; ++m) t[ai][m] = ss[row0 + ai * HALF + m * 16];
#pragma unroll
    for (int ai = 0; ai < 2; ++ai)
#pragma unroll
        for (int m = 0; m < 4; ++m) rs[ai][m] = rsqrtf(t[ai][m] * invn + RMS_EPS) * mul;
}
__device__ __forceinline__ void row_rstd4(float (&rs)[4], const float* ss, int row0, float invn, float mul) {
    float t[4];
#pragma unroll
    for (int m = 0; m < 4; ++m) t[m] = ss[row0 + m * 16];
#pragma unroll
    for (int m = 0; m < 4; ++m) rs[m] = rsqrtf(t[m] * invn + RMS_EPS) * mul;
}
struct EpiQKV {
    static constexpr bool PERM = true, AFTER_DRAIN = false;
    bf16_t* Q; size_t tstride; bf16_t* V; const float* ss; float qscale;
    unsigned* kmax2;
    __device__ __forceinline__ void operator()(const f32x4 (&acc)[2][2][4][2], const Unit& u, int wr, int wc, int fr, int fq) const {
        const int t = u.pn >> 2; bf16_t* base = t < 2 ? Q + (size_t)t * tstride : V; const float sc = t == 0 ? qscale : 1.f;
        const int col0 = (u.pn & 3) * 256 + wc * 32 + 8 * fq;
        float rsv[2][4]; row_rstd(rsv, ss, u.pm * BM + wr * 64 + fr, 1.f / 1024.f, 1.f);
#pragma unroll
        for (int ai = 0; ai < 2; ++ai)
#pragma unroll
            for (int m = 0; m < 4; ++m) { const int row = u.pm * BM + ai * HALF + wr * 64 + m * 16 + fr; const float rs = rsv[ai][m] * sc;
                bf16_t* rowp = base + (size_t)row * 1024 + col0;
#pragma unroll
                for (int bj = 0; bj < 2; ++bj) *(u32x4*)(rowp + bj * HALF) = pack8(acc[ai][bj][m][0] * rs, acc[ai][bj][m][1] * rs); }
        if (t == 1) {
#pragma unroll
            for (int bj = 0; bj < 2; ++bj) { float mx = 0.f;
#pragma unroll
                for (int ai = 0; ai < 2; ++ai)
#pragma unroll
                    for (int m = 0; m < 4; ++m) { const float rs = rsv[ai][m];
                        float s8 = sumsq8(acc[ai][bj][m][0] * rs, acc[ai][bj][m][1] * rs); s8 += __shfl_xor(s8, 16); s8 += __shfl_xor(s8, 32); mx = fmaxf(mx, s8); }
                mx = fmaxf(mx, __shfl_xor(mx, 1)); mx = fmaxf(mx, __shfl_xor(mx, 2)); mx = fmaxf(mx, __shfl_xor(mx, 4)); mx = fmaxf(mx, __shfl_xor(mx, 8));
                if (fr == 0 && fq == 0) atomicMax(kmax2 + ((u.pm >> 5) * 16 + (u.pn & 3) * 4 + bj * 2 + (wc >> 1)) * 2 + (wc & 1), __float_as_uint(mx)); }
        }
    }
};
__device__ __forceinline__ void unpack8(const u32x4 w, f32x4& a, f32x4& b) {
    a[0] = __uint_as_float(w.x << 16); a[1] = __uint_as_float(w.x & 0xffff0000u); a[2] = __uint_as_float(w.y << 16); a[3] = __uint_as_float(w.y & 0xffff0000u);
    b[0] = __uint_as_float(w.z << 16); b[1] = __uint_as_float(w.z & 0xffff0000u); b[2] = __uint_as_float(w.w << 16); b[3] = __uint_as_float(w.w & 0xffff0000u);
}
struct EpiRes {
    static constexpr bool PERM = true, AFTER_DRAIN = false;
    const float* basef; bf16_t* xb; bf16_t* lo; float* ss;
    __device__ __forceinline__ void operator()(const f32x4 (&acc)[2][2][4][2], const Unit& u, int wr, int wc, int fr, int fq) const {
        const int col0 = u.pn * BM + wc * 32 + 8 * fq; const size_t lo_pan = (size_t)u.pm * 262144;
#pragma unroll
        for (int ai = 0; ai < 2; ++ai) {
            f32x4 bv[4][2][2];
#pragma unroll
            for (int m = 0; m < 4; ++m) { const size_t off = (size_t)(u.pm * BM + ai * HALF + wr * 64 + m * 16 + fr) * 1024 + col0;
#pragma unroll
                for (int bj = 0; bj < 2; ++bj) {
                    if (basef) { bv[m][bj][0] = *(const f32x4*)(basef + off + bj * HALF); bv[m][bj][1] = *(const f32x4*)(basef + off + bj * HALF + 4); }
                    else { const u32x4 hw = *(const u32x4*)(xb + off + bj * HALF); f32x4 h0, h1; unpack8(hw, h0, h1);
                        if (lo) { const u32x4 lw = *(const u32x4*)(lo + lo_pan + off + bj * HALF); f32x4 l0, l1; unpack8(lw, l0, l1); h0 += l0; h1 += l1; }
                        bv[m][bj][0] = h0; bv[m][bj][1] = h1; } } }
            asm volatile("" ::: "memory");
#pragma unroll
            for (int m = 0; m < 4; ++m) { const int row = u.pm * BM + ai * HALF + wr * 64 + m * 16 + fr; const size_t off = (size_t)row * 1024 + col0; float s = 0.f;
#pragma unroll
                for (int bj = 0; bj < 2; ++bj) { const size_t o2 = off + bj * HALF; const f32x4 o0 = bv[m][bj][0] + acc[ai][bj][m][0], o1 = bv[m][bj][1] + acc[ai][bj][m][1];
                    s += sumsq8(o0, o1);
                    const u32x4 hw = pack8(o0, o1); f32x4 h0, h1; unpack8(hw, h0, h1);
                    *(u32x4*)(xb + o2) = hw; if (lo) *(u32x4*)(lo + lo_pan + o2) = pack8(o0 - h0, o1 - h1); }
                s += __shfl_xor(s, 16); s += __shfl_xor(s, 32);
                if (fq == 0) atomicAdd(ss + row, s); }
            asm volatile("" ::: "memory");
        }
    }
};
struct EpiResFinal {
    static constexpr bool PERM = true, AFTER_DRAIN = true;
    const bf16_t* xb; const bf16_t* lo; float* out; float* ss; const float* g; unsigned* cnt;
    __device__ __forceinline__ void fused(f32x4 (&acc)[2][2][4][2], const Unit& u, int wr, int wc, int fr, int fq, PG8_LAS unsigned char* lds, int wid, int lane) const {
        const int col0 = u.pn * BM + wc * 32 + 8 * fq; const size_t lo_pan = (size_t)u.pm * 262144;
#pragma unroll
        for (int ai = 0; ai < 2; ++ai) {
            u32x4 hv[4][2], lv[4][2];
#pragma unroll
            for (int m = 0; m < 4; ++m) { const size_t off = (size_t)(u.pm * BM + ai * HALF + wr * 64 + m * 16 + fr) * 1024 + col0;
#pragma unroll
                for (int bj = 0; bj < 2; ++bj) { hv[m][bj] = *(const u32x4*)(xb + off + bj * HALF); lv[m][bj] = lo ? *(const u32x4*)(lo + lo_pan + off + bj * HALF) : (u32x4){0u, 0u, 0u, 0u}; } }
            asm volatile("" ::: "memory");
#pragma unroll
            for (int m = 0; m < 4; ++m) { const int row = u.pm * BM + ai * HALF + wr * 64 + m * 16 + fr; float s = 0.f;
#pragma unroll
                for (int bj = 0; bj < 2; ++bj) { f32x4 h0, h1, l0, l1; unpack8(hv[m][bj], h0, h1); unpack8(lv[m][bj], l0, l1);
                    const f32x4 o0 = (h0 + l0) + acc[ai][bj][m][0], o1 = (h1 + l1) + acc[ai][bj][m][1]; acc[ai][bj][m][0] = o0; acc[ai][bj][m][1] = o1; s += sumsq8(o0, o1); }
                s += __shfl_xor(s, 16); s += __shfl_xor(s, 32);
                if (fq == 0) atomicAdd(ss + row, s); }
            asm volatile("" ::: "memory");
        }
        asm volatile("s_waitcnt vmcnt(0)" ::: "memory");
        __syncthreads();
        if (wid == 0 && lane == 0) {
            __builtin_amdgcn_fence(__ATOMIC_RELEASE, "agent");
            unsigned* c = cnt + 64 * u.pm;
            __hip_atomic_fetch_add(c, 1u, __ATOMIC_RELAXED, __HIP_MEMORY_SCOPE_AGENT);
            unsigned spins = 0u;
            while (__hip_atomic_load(c, __ATOMIC_RELAXED, __HIP_MEMORY_SCOPE_AGENT) < 4u) { __builtin_amdgcn_s_sleep(2); if (++spins > (1u << 22)) break; }
            __builtin_amdgcn_fence(__ATOMIC_ACQUIRE, "agent");
        }
        __syncthreads();
        f32x4 gv[2][2];
#pragma unroll
        for (int bj = 0; bj < 2; ++bj)
#pragma unroll
            for (int n = 0; n < 2; ++n) gv[bj][n] = *(const f32x4*)(g + col0 + bj * HALF + n * 4);
        float ssv[2][4];
#pragma unroll
        for (int ai = 0; ai < 2; ++ai)
#pragma unroll
            for (int m = 0; m < 4; ++m) ssv[ai][m] = __hip_atomic_load(ss + u.pm * BM + ai * HALF + wr * 64 + m * 16 + fr, __ATOMIC_RELAXED, __HIP_MEMORY_SCOPE_AGENT);
#pragma unroll
        for (int ai = 0; ai < 2; ++ai)
#pragma unroll
            for (int m = 0; m < 4; ++m) { const int row = u.pm * BM + ai * HALF + wr * 64 + m * 16 + fr; const size_t off = (size_t)row * 1024 + col0; const float rstd = rsqrtf(ssv[ai][m] * (1.f / 1024.f) + RMS_EPS);
#pragma unroll
                for (int bj = 0; bj < 2; ++bj)
#pragma unroll
                    for (int n = 0; n < 2; ++n) *(f32x4*)(out + off + bj * HALF + n * 4) = acc[ai][bj][m][n] * rstd * gv[bj][n]; }
    }
};
struct EpiUp {
    static constexpr bool PERM = true, AFTER_DRAIN = false;
    bf16_t* H; const float* ss;
    __device__ __forceinline__ void operator()(const f32x4 (&acc)[2][2][4][2], const Unit& u, int wr, int wc, int fr, int fq) const {
        const int col0 = u.pn * BM + wc * 32 + 8 * fq;
        float rsv[2][4]; row_rstd(rsv, ss, u.pm * BM + wr * 64 + fr, 1.f / 1024.f, 1.f);
#pragma unroll
        for (int ai = 0; ai < 2; ++ai)
#pragma unroll
            for (int m = 0; m < 4; ++m) { const int row = u.pm * BM + ai * HALF + wr * 64 + m * 16 + fr; const float rs = rsv[ai][m];
                bf16_t* rowp = H + (size_t)row * 4096 + col0;
#pragma unroll
                for (int bj = 0; bj < 2; ++bj) { f32x4 a = acc[ai][bj][m][0] * rs, b = acc[ai][bj][m][1] * rs;
#pragma unroll
                    for (int j = 0; j < 4; ++j) { a[j] = fmaxf(a[j], 0.f); a[j] *= a[j]; b[j] = fmaxf(b[j], 0.f); b[j] *= b[j]; }
                    *(u32x4*)(rowp + bj * HALF) = pack8(a, b); } }
    }
};
struct EpiQKVA {
    static constexpr bool PERM = true, AFTER_DRAIN = false;
    bf16_t* CKV; bf16_t* QA; bf16_t* KR; const float* ss; float* ss_kv; float* ss_q; const float* rope;
    __device__ __forceinline__ void operator()(const f32x4 (&acc)[2][2][4][2], const Unit& u, int wr, int wc, int fr, int fq) const {
        const int cb = wc * 32 + 8 * fq;
        float rsv[2][4]; row_rstd(rsv, ss, u.pm * BM + wr * 64 + fr, 1.f / 1024.f, 1.f);
#pragma unroll
        for (int ai = 0; ai < 2; ++ai)
#pragma unroll
            for (int m = 0; m < 4; ++m) { const int row = u.pm * BM + ai * HALF + wr * 64 + m * 16 + fr; const float rs = rsv[ai][m];
                float s = 0.f;
#pragma unroll
                for (int bj = 0; bj < 2; ++bj) { f32x4 a = acc[ai][bj][m][0] * rs, b = acc[ai][bj][m][1] * rs;
                    if (u.pn == 0) { *(u32x4*)(CKV + (size_t)row * 256 + bj * HALF + cb) = pack8(a, b); s += sumsq8(a, b); }
                    else if (u.pn == 1) { *(u32x4*)(QA + (size_t)row * 384 + bj * HALF + cb) = pack8(a, b); s += sumsq8(a, b); }
                    else if (bj == 0) { *(u32x4*)(QA + (size_t)row * 384 + 256 + cb) = pack8(a, b); s += sumsq8(a, b); }
                    else if (wc < 2) { rope8(a, b, rope + ((size_t)(row & 8191) * 32 + (cb >> 1)) * 2); *(u32x4*)(KR + (size_t)row * 64 + cb) = pack8(a, b); } }
                s += __shfl_xor(s, 16); s += __shfl_xor(s, 32);
                if (fq == 0) atomicAdd((u.pn == 0 ? ss_kv : ss_q) + row, s); }
    }
};
struct EpiKVB {
    static constexpr bool PERM = true, AFTER_DRAIN = false;
    bf16_t* KV; const float* ss_kv;
    __device__ __forceinline__ void operator()(const f32x4 (&acc)[2][2][4][2], const Unit& u, int wr, int wc, int fr, int fq) const {
        const int col0 = u.pn * BM + wc * 32 + 8 * fq;
#pragma unroll
        for (int ai = 0; ai < 2; ++ai) { float rs4[4]; row_rstd4(rs4, ss_kv, u.pm * BM + ai * HALF + wr * 64 + fr, 1.f / 256.f, 1.f);
#pragma unroll
            for (int m = 0; m < 4; ++m) { const int row = u.pm * BM + ai * HALF + wr * 64 + m * 16 + fr; const float rs = rs4[m];
                bf16_t* rowp = KV + (size_t)row * 2048 + col0;
#pragma unroll
                for (int bj = 0; bj < 2; ++bj) *(u32x4*)(rowp + bj * HALF) = pack8(acc[ai][bj][m][0] * rs, acc[ai][bj][m][1] * rs); }
            asm volatile("" ::: "memory"); }
    }
};
struct EpiQB {
    static constexpr bool PERM = true, AFTER_DRAIN = false;
    bf16_t* Q; const float* ss_q; float qscale;
    __device__ __forceinline__ void operator()(const f32x4 (&acc)[2][2][4][2], const Unit& u, int wr, int wc, int fr, int fq) const {
        const int col0 = u.pn * BM + wc * 32 + 8 * fq;
#pragma unroll
        for (int ai = 0; ai < 2; ++ai) { float rs4[4]; row_rstd4(rs4, ss_q, u.pm * BM + ai * HALF + wr * 64 + fr, 1.f / 384.f, qscale);
#pragma unroll
            for (int m = 0; m < 4; ++m) { const int row = u.pm * BM + ai * HALF + wr * 64 + m * 16 + fr; const float rs = rs4[m];
                bf16_t* rowp = Q + (size_t)row * 1536 + col0;
#pragma unroll
                for (int bj = 0; bj < 2; ++bj) { f32x4 a = acc[ai][bj][m][0] * rs, b = acc[ai][bj][m][1] * rs;
                    *(u32x4*)(rowp + bj * HALF) = pack8(a, b); } }
            asm volatile("" ::: "memory"); }
    }
};
}
namespace att {
typedef unsigned short bf16_t;
typedef short bf16x8 __attribute__((ext_vector_type(8)));
typedef short s16x4 __attribute__((ext_vector_type(4)));
typedef float f32x16 __attribute__((ext_vector_type(16)));
typedef float f32x4 __attribute__((ext_vector_type(4)));
typedef unsigned u32x4 __attribute__((ext_vector_type(4)));
#define ASBAR() __builtin_amdgcn_sched_barrier(0)
constexpr double LOG2E_D = 1.4426950408889634;
__device__ __forceinline__ int v_st(int k, int c) { const int kk = (k & ~0xC) | ((k & 4) << 1) | ((k & 8) >> 1); return ((kk >> 3) * 4 + (c >> 5)) * 512 + ((kk & 7) * 32 + (c & 31)) * 2; }
__device__ __forceinline__ int v_rd_base(int lane) { return ((lane & 3) << 3) | (((lane >> 2) & 3) << 6) | (((lane >> 4) & 1) << 5) | (((lane >> 5) & 1) << 8); }
__device__ __forceinline__ int crow(int r, int hi) { return (r & 3) + 8 * (r >> 2) + 4 * hi; }
__device__ __forceinline__ unsigned cvtpk(float lo, float hi) { unsigned r; asm volatile("v_cvt_pk_bf16_f32 %0, %1, %2" : "=v"(r) : "v"(lo), "v"(hi)); return r; }

struct Unit {
    const bf16_t* q[2]; int qs;
    const bf16_t* kA; int ksA;
    const bf16_t* kB; int ksB;
    const bf16_t* v; int vs;
    bf16_t* o; int os;
    const double* c;
    const unsigned* kmax2;
    const float* rtab;
    int q0, j_lo;
};
template <int DQK, int DV, bool BIAS> struct Lay {
    static constexpr int KROWB = DQK * 2, SHM_K = 64 * KROWB, SHM_V = 16384;
    static constexpr int OFF_K = 2 * SHM_V, OFF_WS = OFF_K + 2 * SHM_K, OFF_CK = OFF_WS + 2048, BYTES = OFF_CK + 32768;
};

template <int DQK, int DV, bool BIAS>
__device__ __forceinline__ void attn_unit(const Unit& U, char* lds) {
    typedef Lay<DQK, DV, BIAS> L;
    constexpr int NKB = DQK / 64, NVB = DV / 64, NQF = DQK / 16, NOD = DV / 32, KROWB = L::KROWB, SHM_K = L::SHM_K, SHM_V = L::SHM_V;
    int tid_ = threadIdx.x; asm volatile("" : "+v"(tid_));
    const int tid = tid_, wid = __builtin_amdgcn_readfirstlane(tid >> 6), lane = tid & 63, r32 = lane & 31, hi = lane >> 5;
    char* V_lds = lds; char* K_lds = lds + L::OFF_K;
    float* ws = (float*)(lds + L::OFF_WS) + wid * 64; float* li_l = ws; float* al_l = ws + 32;
    float* ckL = (float*)(lds + L::OFF_CK);
    const int q0 = U.q0;
    const int qlo = q0 + wid * 32, qrow = qlo + r32, qm = qrow - 4 * hi;
    const int vb0 = (int)(uintptr_t)V_lds + v_rd_base(lane);
    const unsigned lds0 = (unsigned)(uintptr_t)lds;
    const bf16_t* ksrc[NKB]; int kstep[NKB]; const bf16_t* vsrc[NVB];
#define A_SRCSETUP(KLO_) do { \
_Pragma("unroll") \
    for (int i = 0; i < NKB; ++i) { const int B_ = (wid * NKB + i) * 1024 + lane * 16, row = B_ / KROWB, ph = (B_ % KROWB) >> 4, lg = (ph & ~7) | ((ph & 7) ^ ((row >> 1) & 7)), col = lg * 8, blk = col >> 6; \
        const bool hiB = blk >= 2; const int st_ = hiB ? U.ksB : U.ksA; const size_t eo_ = (size_t)((KLO_) + row) * st_ + (hiB ? col - 128 : col); \
        ksrc[i] = (hiB ? U.kB : U.kA) + eo_; kstep[i] = 64 * st_; } \
_Pragma("unroll") \
    for (int i = 0; i < NVB; ++i) { const int B_ = (wid * NVB + i) * (DV == 64 ? 2048 : 1024) + lane * 16, st_ = B_ >> 9, e_ = (B_ & 511) >> 1, kk_ = (st_ >> 2) * 8 + (e_ >> 5); \
        const int k_ = (kk_ & ~0xC) | ((kk_ & 4) << 1) | ((kk_ & 8) >> 1), c_ = (st_ & 3) * 32 + (e_ & 31); \
        vsrc[i] = U.v + (size_t)((KLO_) + k_) * U.vs + c_; } \
    } while (0)
#define A_GLDS(gsrc, ldsdst) do { unsigned keep_; asm volatile("s_mov_b32 %0, m0\n\ts_mov_b32 m0, %2\n\ts_nop 0\n\tglobal_load_lds_dwordx4 %1, off\n\ts_mov_b32 m0, %0" : "=&s"(keep_) : "v"(gsrc), "s"(ldsdst) : "memory"); } while (0)
#define A_DMA(bf) do { \
        _Pragma("unroll") for (int i_ = 0; i_ < NKB; ++i_) { A_GLDS(ksrc[i_], (unsigned)__builtin_amdgcn_readfirstlane(lds0 + L::OFF_K + (bf) * SHM_K + (wid * NKB + i_) * 1024)); ksrc[i_] += kstep[i_]; } \
        _Pragma("unroll") for (int i_ = 0; i_ < NVB; ++i_) { A_GLDS(vsrc[i_], (unsigned)__builtin_amdgcn_readfirstlane(lds0 + (bf) * SHM_V + (wid * NVB + i_) * (DV == 64 ? 2048 : 1024))); vsrc[i_] += 64 * U.vs; } } while (0)
#define A_DMAWAIT() asm volatile("s_waitcnt vmcnt(0)" ::: "memory")
    double c0_ = 0.0, cqd_ = 0.0, csk_ = 0.0; unsigned k2a_ = 0u, k2b_ = 0u;
    if constexpr (BIAS) { c0_ = U.c[U.q0]; cqd_ = U.c[U.q0 + wid * 32 + r32]; if (tid < U.q0 / 64) csk_ = U.c[64 * tid + 63]; k2a_ = U.kmax2[0]; k2b_ = U.kmax2[1]; }
    else { A_SRCSETUP(U.j_lo * 64); A_DMA(0); }
    bf16x8 qr[NQF];
#pragma unroll
    for (int d0 = 0; d0 < NQF; ++d0) qr[d0] = *(const bf16x8*)(U.q[d0 >> 3] + (size_t)qrow * U.qs + (d0 & 7) * 16 + hi * 8);
    if constexpr (DQK == 192) {
#pragma unroll
        for (int d0 = 8; d0 < 12; ++d0) { const float* tab = U.rtab + ((size_t)qrow * 32 + 8 * (d0 - 8) + 4 * hi) * 2; const f32x4 t0 = *(const f32x4*)tab, t1 = *(const f32x4*)(tab + 4);
            const u32x4 w = *reinterpret_cast<const u32x4*>(&qr[d0]); u32x4 ov;
#pragma unroll
            for (int j = 0; j < 4; ++j) { const float a = __uint_as_float(w[j] << 16), b = __uint_as_float(w[j] & 0xffff0000u); const float c_ = j < 2 ? t0[2 * (j & 1)] : t1[2 * (j & 1)], s_ = j < 2 ? t0[2 * (j & 1) + 1] : t1[2 * (j & 1) + 1];
                ov[j] = cvtpk(a * c_ - b * s_, b * c_ + a * s_); }
            qr[d0] = *reinterpret_cast<const bf16x8*>(&ov); }
        char* qL_ = lds + L::OFF_CK + wid * 4096 + lane * 16;
#pragma unroll
        for (int d0 = 8; d0 < 12; ++d0) { *(bf16x8*)(qL_ + (d0 - 8) * 1024) = qr[d0]; }
        asm volatile("" ::: "memory"); }
    const char* qL = lds + L::OFF_CK + wid * 4096 + lane * 16;
    int j_lo = U.j_lo;
    if constexpr (BIAS) {
        float qn2 = 0.f;
#pragma unroll
        for (int d0 = 0; d0 < NQF; ++d0) { const u32x4 w = *reinterpret_cast<const u32x4*>(&qr[d0]);
#pragma unroll
            for (int j = 0; j < 4; ++j) { const float a = __uint_as_float(w[j] << 16), b = __uint_as_float(w[j] & 0xffff0000u); qn2 += a * a + b * b; } }
        { auto rr = __builtin_amdgcn_permlane32_swap(__float_as_uint(qn2), __float_as_uint(qn2), false, false); qn2 = __uint_as_float(rr[0]) + __uint_as_float(rr[1]); }
#pragma unroll
        for (int o_ = 1; o_ < 32; o_ <<= 1) qn2 = fmaxf(qn2, __shfl_xor(qn2, o_));
        float* wsb = (float*)(lds + L::OFF_WS);
        if (lane == 0) wsb[wid * 64] = qn2;
        __syncthreads();
        float qmax2 = wsb[0];
#pragma unroll
        for (int w = 1; w < 8; ++w) qmax2 = fmaxf(qmax2, wsb[w * 64]);
        const float k2 = __uint_as_float(k2a_) + __uint_as_float(k2b_);
        const float thr = 2.f * (sqrtf(qmax2 * k2) * 1.02f + 1e-3f) + 160.f;
        const int nprev = q0 / 64;
        bool sk = false; if (tid < nprev) sk = (float)((csk_ - c0_) * LOG2E_D) > thr;
        const unsigned long long bal = __ballot(sk);
        if (lane == 0) ((int*)wsb)[wid * 64 + 1] = __popcll(bal);
        __syncthreads();
        int cnt = 0;
#pragma unroll
        for (int w = 0; w < 8; ++w) cnt += ((int*)wsb)[w * 64 + 1];
        j_lo = cnt;
    }
    const int klo = j_lo * 64, NT = (q0 + 256) / 64 - j_lo;
    float cq = 0.f;
    if constexpr (BIAS) { A_SRCSETUP(klo); A_DMA(0);
        const double cref = c0_; cq = (float)((cqd_ - cref) * LOG2E_D);
        for (int s = klo + tid; s < q0 + 256; s += 512) ckL[s - klo] = (float)((U.c[s] - cref) * LOG2E_D); }
    A_DMAWAIT();
    __syncthreads();
    float mhat = 0.f, l_reg = 0.f; f32x16 o[NOD]; f32x16 negm; _Pragma("unroll") for (int r = 0; r < 16; ++r) negm[r] = cq; asm volatile("" : "+v"(negm));
#pragma unroll
    for (int d = 0; d < NOD; ++d) o[d] = f32x16{};
    const char* kbase = K_lds + r32 * KROWB;
    const int ksw = ((r32 >> 1) & 7) << 4;
#define A_TRRD(dst, off) asm volatile("ds_read_b64_tr_b16 %0, %1 offset:%2" : "=&v"(dst) : "v"(vb0), "i"(off) : "memory")
#define A_PV_RD(X, d0, BUF) do { constexpr int b_ = (BUF) * SHM_V + (d0) * 512; \
        A_TRRD(X##l0, b_); A_TRRD(X##h0, b_ + 2048); A_TRRD(X##l1, b_ + 4096); A_TRRD(X##h1, b_ + 6144); A_TRRD(X##l2, b_ + 8192); A_TRRD(X##h2, b_ + 10240); A_TRRD(X##l3, b_ + 12288); A_TRRD(X##h3, b_ + 14336); } while (0)
#define A_PV_MM(X, d0) do { \
        o[d0] = __builtin_amdgcn_mfma_f32_32x32x16_bf16(pa0, (bf16x8){X##l0[0], X##l0[1], X##l0[2], X##l0[3], X##h0[0], X##h0[1], X##h0[2], X##h0[3]}, o[d0], 0, 0, 0); \
        o[d0] = __builtin_amdgcn_mfma_f32_32x32x16_bf16(pa1, (bf16x8){X##l1[0], X##l1[1], X##l1[2], X##l1[3], X##h1[0], X##h1[1], X##h1[2], X##h1[3]}, o[d0], 0, 0, 0); \
        o[d0] = __builtin_amdgcn_mfma_f32_32x32x16_bf16(pa2, (bf16x8){X##l2[0], X##l2[1], X##l2[2], X##l2[3], X##h2[0], X##h2[1], X##h2[2], X##h2[3]}, o[d0], 0, 0, 0); \
        o[d0] = __builtin_amdgcn_mfma_f32_32x32x16_bf16(pa3, (bf16x8){X##l3[0], X##l3[1], X##l3[2], X##l3[3], X##h3[0], X##h3[1], X##h3[2], X##h3[3]}, o[d0], 0, 0, 0); } while (0)
#define A_LGKM(n) do { asm volatile("s_waitcnt lgkmcnt(" #n ")" ::: "memory"); ASBAR(); } while (0)
#define A_PV_ALL(BUF) do { s16x4 al0, al1, al2, al3, ah0, ah1, ah2, ah3, bl0, bl1, bl2, bl3, bh0, bh1, bh2, bh3; \
        A_PV_RD(a, 0, BUF); A_PV_RD(b, 1, BUF); A_LGKM(8); A_PV_MM(a, 0); ASBAR(); \
        if constexpr (NOD > 2) { A_PV_RD(a, 2 % NOD, BUF); A_LGKM(8); A_PV_MM(b, 1); ASBAR(); A_PV_RD(b, 3 % NOD, BUF); A_LGKM(8); A_PV_MM(a, 2 % NOD); ASBAR(); A_LGKM(0); A_PV_MM(b, 3 % NOD); } \
        else { A_LGKM(0); A_PV_MM(b, 1); } } while (0)
#define A_PK4(P, B_, OUT) do { unsigned a0 = cvtpk(P[B_ + 0], P[B_ + 1]), a1 = cvtpk(P[B_ + 2], P[B_ + 3]); unsigned b0 = cvtpk(P[B_ + 4], P[B_ + 5]), b1 = cvtpk(P[B_ + 6], P[B_ + 7]); \
        auto r0 = __builtin_amdgcn_permlane32_swap(a0, b0, false, false); auto r1 = __builtin_amdgcn_permlane32_swap(a1, b1, false, false); \
        u32x4 w = {r0[0], r1[0], r0[1], r1[1]}; OUT = *reinterpret_cast<bf16x8*>(&w); } while (0)
#define A_TILE(BUF, t, FIRST) do { \
        const int kb_ = klo + (t) * 64; const bool more_ = (t) + 1 < NT; \
        if (more_) A_DMA(1 - (BUF)); \
        ASBAR(); \
        f32x16 p0, p1; \
        _Pragma("unroll") for (int d0 = 0; d0 < NQF; ++d0) { const char* a_ = kbase + (BUF) * SHM_K + (d0 >> 2) * 128 + ((((d0 & 3) * 32) + hi * 16) ^ ksw); \
            const bf16x8 b0 = *(const bf16x8*)a_; const bf16x8 b1 = *(const bf16x8*)(a_ + 32 * KROWB); \
            const bf16x8 qf_ = d0 < 8 ? qr[d0 < 8 ? d0 : 0] : *(const bf16x8*)(qL + (d0 - 8) * 1024); \
            if (d0 == 0) { p0 = __builtin_amdgcn_mfma_f32_32x32x16_bf16(b0, qf_, negm, 0, 0, 0); p1 = __builtin_amdgcn_mfma_f32_32x32x16_bf16(b1, qf_, negm, 0, 0, 0); } \
            else { p0 = __builtin_amdgcn_mfma_f32_32x32x16_bf16(b0, qf_, p0, 0, 0, 0); p1 = __builtin_amdgcn_mfma_f32_32x32x16_bf16(b1, qf_, p1, 0, 0, 0); } if ((d0 & 1) == 1) ASBAR(); } \
        ASBAR(); \
        if constexpr (BIAS) { const float* ck_ = ckL + (kb_ - klo) + 4 * hi; \
            f32x16 cv0, cv1; \
            _Pragma("unroll") for (int g = 0; g < 4; ++g) { const f32x4 c0 = *(const f32x4*)(ck_ + 8 * g), c1 = *(const f32x4*)(ck_ + 32 + 8 * g); \
                _Pragma("unroll") for (int j = 0; j < 4; ++j) { cv0[4 * g + j] = c0[j]; cv1[4 * g + j] = c1[j]; } } \
            p0 = p0 - cv0; p1 = p1 - cv1; }     \
        if (kb_ + 63 > qlo) { const float NEG = -__builtin_inff(); const int dq = qm - kb_; \
            _Pragma("unroll") for (int r = 0; r < 16; ++r) { const int c = (r & 3) + 8 * (r >> 2); if (dq - c < 0) p0[r] = NEG; if (dq - c - 32 < 0) p1[r] = NEG; } } \
        float pmax = __builtin_fmaxf(__builtin_fmaxf(p0[0], p0[1]), p1[0]); float pmb = __builtin_fmaxf(__builtin_fmaxf(p0[2], p0[3]), p1[1]); pmax = __builtin_fmaxf(__builtin_fmaxf(pmax, p1[2]), p1[3]); \
        _Pragma("unroll") for (int r = 4; r < 16; r += 4) { pmax = __builtin_fmaxf(__builtin_fmaxf(pmax, p0[r]), p0[r + 1]); pmb = __builtin_fmaxf(__builtin_fmaxf(pmb, p0[r + 2]), p0[r + 3]); \
            pmax = __builtin_fmaxf(__builtin_fmaxf(pmax, p1[r]), p1[r + 1]); pmb = __builtin_fmaxf(__builtin_fmaxf(pmb, p1[r + 2]), p1[r + 3]); } \
        pmax = __builtin_fmaxf(pmax, pmb); \
        { auto rr = __builtin_amdgcn_permlane32_swap(__float_as_uint(pmax), __float_as_uint(pmax), false, false); pmax = fmaxf(__uint_as_float(rr[0]), __uint_as_float(rr[1])); } \
        if ((FIRST) || __any(pmax > 8.f)) { const float dl = (FIRST) ? pmax : fmaxf(pmax, 0.f); mhat += dl; \
            _Pragma("unroll") for (int r = 0; r < 16; ++r) { p0[r] -= dl; p1[r] -= dl; } \
            _Pragma("unroll") for (int r = 0; r < 16; ++r) negm[r] = cq - mhat; asm volatile("" : "+v"(negm)); \
            if (!(FIRST)) { const float alpha = __builtin_amdgcn_exp2f(-dl); l_reg *= alpha; if (hi == 0) al_l[r32] = alpha; asm volatile("s_waitcnt lgkmcnt(0)" ::: "memory"); \
                _Pragma("unroll") for (int d_ = 0; d_ < NOD; ++d_) _Pragma("unroll") for (int r = 0; r < 16; ++r) o[d_][r] *= al_l[crow(r, hi)]; } } \
        _Pragma("unroll") for (int r = 0; r < 16; ++r) { p0[r] = __builtin_amdgcn_exp2f(p0[r]); p1[r] = __builtin_amdgcn_exp2f(p1[r]); } \
        { const f32x16 sv = p0 + p1; float ps = ((sv[0] + sv[1]) + (sv[2] + sv[3])) + ((sv[4] + sv[5]) + (sv[6] + sv[7])) + (((sv[8] + sv[9]) + (sv[10] + sv[11])) + ((sv[12] + sv[13]) + (sv[14] + sv[15]))); \
          auto rr = __builtin_amdgcn_permlane32_swap(__float_as_uint(ps), __float_as_uint(ps), false, false); l_reg += __uint_as_float(rr[0]) + __uint_as_float(rr[1]); } \
        bf16x8 pa0, pa1, pa2, pa3; A_PK4(p0, 0, pa0); A_PK4(p0, 8, pa1); A_PK4(p1, 0, pa2); A_PK4(p1, 8, pa3); \
        ASBAR(); \
        A_PV_ALL(BUF); \
        A_DMAWAIT(); \
        __syncthreads(); } while (0)
    A_TILE(0, 0, true);
    int t = 1;
    for (; t + 1 < NT; t += 2) { A_TILE(1, t, false); A_TILE(0, t + 1, false); }
    if (t < NT) { A_TILE(1, t, false); }
    if (hi == 0) li_l[r32] = l_reg; asm volatile("s_waitcnt lgkmcnt(0)" ::: "memory");
    bf16_t* Ow = U.o + (size_t)qlo * U.os;
#pragma unroll
    for (int r = 0; r < 16; ++r) { const int orow = crow(r, hi); const float rl = __builtin_amdgcn_rcpf(li_l[orow]);
#pragma unroll
        for (int d0 = 0; d0 < NOD; ++d0) { const float v = o[d0][r] * rl; const float vn = __shfl_xor(v, 1);
            if ((r32 & 1) == 0) *(unsigned*)(Ow + (size_t)orow * U.os + d0 * 32 + r32) = cvtpk(v, vn); } }
    __syncthreads();
#undef A_GLDS
#undef A_SRCSETUP
#undef A_DMA
#undef A_DMAWAIT
#undef A_TRRD
#undef A_PV_RD
#undef A_PV_MM
#undef A_PV_ALL
#undef A_LGKM
#undef A_PK4
#undef A_TILE
}
}
#define LAS __attribute__((address_space(3)))
#define XB_TMO      128
#define XB_XCNT(j)  (256  + 64 * (j))
#define XB_XSUB(j)  (1280 + 64 * (j))
#define XB_XGEN(j)  (2304 + 64 * (j))
#define XB_TOP      3328
#define XB_TOPGEN   3392
#define XCD_BAR_WORDS 3456
#define XB_SPIN_CAP (1u << 18)

__device__ __forceinline__ unsigned xb_ld(unsigned* p)              { return __hip_atomic_load(p, __ATOMIC_RELAXED, __HIP_MEMORY_SCOPE_AGENT); }
__device__ __forceinline__ unsigned xb_add(unsigned* p, unsigned v) { return __hip_atomic_fetch_add(p, v, __ATOMIC_RELAXED, __HIP_MEMORY_SCOPE_AGENT); }
__device__ __forceinline__ unsigned xb_xcc_id() { return (unsigned)__builtin_amdgcn_s_getreg((3 << 11) | 20) & 0xFu; }
#define XB_SPIN(cond, bar) do { unsigned _sp = 0; while (cond) { __builtin_amdgcn_s_sleep(1); \
    if ((++_sp & 255u) == 0u) { if (xb_ld(&(bar)[XB_TMO])) break; if (_sp > XB_SPIN_CAP) { atomicAdd(&(bar)[XB_TMO], 1u); break; } } } } while (0)

struct XcdBarrier {
    unsigned* bar; unsigned x;
    volatile LAS unsigned* st;
};

__device__ __forceinline__ XcdBarrier xcd_barrier_post(unsigned* bar, volatile LAS unsigned* st) {
    XcdBarrier b; b.bar = bar; b.x = xb_xcc_id(); b.st = st;
    if (threadIdx.x == 0) (void)xb_add(&bar[XB_XCNT(b.x)], 1u);
    return b;
}
__device__ __forceinline__ void xcd_barrier_complete(unsigned* bar, unsigned x, unsigned& nloc, unsigned& nx) {
    const unsigned G = gridDim.x * gridDim.y * gridDim.z;
    unsigned sum, cnt, mine, sp = 0u;
    for (;;) {
        sum = 0u; cnt = 0u; mine = 0u;
#pragma unroll
        for (unsigned j = 0; j < 16; ++j) { const unsigned c = xb_ld(&bar[XB_XCNT(j)]); sum += c; cnt += (c > 0u) ? 1u : 0u; mine = (j == x) ? c : mine; }
        if (sum == G) break;
        __builtin_amdgcn_s_sleep(1);
        if ((++sp & 255u) == 0u) { if (xb_ld(&bar[XB_TMO])) break; if (sp > XB_SPIN_CAP) { atomicAdd(&bar[XB_TMO], 1u); break; } }
    }
    nloc = mine > 0u ? mine : 1u; nx = cnt > 0u ? cnt : 1u;
}

__device__ __forceinline__ void xcd_barrier(const XcdBarrier& b) {
    asm volatile("s_waitcnt vmcnt(0)" ::: "memory");
    __syncthreads();
    if (threadIdx.x == 0) {
        unsigned* bar = b.bar;
        __builtin_amdgcn_s_waitcnt(0);
        unsigned nloc = b.st[0], nx = b.st[1];
        if (nloc == 0u) { xcd_barrier_complete(bar, b.x, nloc, nx); b.st[0] = nloc; b.st[1] = nx; }
        const unsigned old = xb_add(&bar[XB_XSUB(b.x)], 1u);
        const unsigned gen = old / nloc;
        if (old + 1u == (gen + 1u) * nloc) {
            __builtin_amdgcn_fence(__ATOMIC_RELEASE, "agent");
            asm volatile("s_waitcnt vmcnt(0)" ::: "memory");
            const unsigned og = xb_add(&bar[XB_TOP], 1u);
            const unsigned tg = og / nx;
            if (og + 1u == (tg + 1u) * nx) xb_add(&bar[XB_TOPGEN], 1u);
            else XB_SPIN(xb_ld(&bar[XB_TOPGEN]) == tg, bar);
            __builtin_amdgcn_fence(__ATOMIC_ACQUIRE, "agent");
            xb_add(&bar[XB_XGEN(b.x)], 1u);
            asm volatile("s_waitcnt vmcnt(0)" ::: "memory");
        } else {
            XB_SPIN(xb_ld(&bar[XB_XGEN(b.x)]) == gen, bar);
            __builtin_amdgcn_fence(__ATOMIC_ACQUIRE, "agent");
            asm volatile("s_waitcnt vmcnt(0)" ::: "memory");
        }
    }
    __syncthreads();
}
typedef unsigned short bf16;
typedef unsigned v4u __attribute__((ext_vector_type(4)));
typedef float f32x4 __attribute__((ext_vector_type(4)));
constexpr int NWAVES = 8, M = 16384, SEQ = 8192, D = 1024, FF = 4096;
constexpr float RMS_EPS = 1e-6f;
constexpr float C2_FOX = 0.125f * 1.4426950408889634f;
constexpr float C2_MLA = 0.07216878364870323f * 1.4426950408889634f;
constexpr size_t MiB = 1u << 20;
constexpr size_t WS_CTL = 0, CTL_ZERO_BYTES = 1 * MiB;
constexpr size_t WS_ROPE = 1 * MiB, WS_LF = 3 * MiB, WS_C = 4 * MiB;
constexpr size_t WS_W = 8 * MiB;
constexpr size_t W_FIN = WS_W, W_FOUT = W_FIN + 6 * MiB, W_QKVA = W_FOUT + 2 * MiB, W_KVB = W_QKVA + 2 * MiB, W_QB = W_KVB + 1 * MiB, W_MOUT = W_QB + 2 * MiB,
                 W_UP0 = W_MOUT + 2 * MiB, W_UP1 = W_UP0 + 8 * MiB, W_DN0 = W_UP1 + 8 * MiB, W_DN1 = W_DN0 + 8 * MiB, W_END = W_DN1 + 8 * MiB;
constexpr size_t WS_XB = 56 * MiB;
constexpr size_t WS_H = 88 * MiB;
constexpr size_t WS_MKV = 88 * MiB, WS_MQ = 152 * MiB, WS_MKR = 248 * MiB  , WS_MO = 216 * MiB  , WS_CKV = 234 * MiB, WS_QA = 242 * MiB, WS_END = 254 * MiB;
static_assert(W_END <= WS_XB, "weights");
constexpr int SS_WORDS = 16384;
enum { SS0 = 1, SS1 = 2, SS2 = 3, SSKV = 4, SSQ = 5, SS3 = 6, SS4 = 7 };
constexpr int LDS_BYTES = 147456;

#define LDS_WAIT() asm volatile("s_waitcnt lgkmcnt(0)" ::: "memory")
__device__ __forceinline__ unsigned f2bf(float f) { unsigned u = __builtin_bit_cast(unsigned, f); return (u + 0x7fffu + ((u >> 16) & 1u)) >> 16; }
__device__ __forceinline__ unsigned pk2(float lo, float hi) { return f2bf(lo) | (f2bf(hi) << 16); }
__device__ __forceinline__ float wave_sum(float v) {
#pragma unroll
    for (int o = 1; o < 64; o <<= 1) v += __shfl_xor(v, o);
    return v;
}
__device__ __forceinline__ double wave_sum_d(double v) {
#pragma unroll
    for (int o = 1; o < 64; o <<= 1) { const int thi = __shfl_xor(__double2hiint(v), o), tlo = __shfl_xor(__double2loint(v), o); v += __hiloint2double(thi, tlo); }
    return v;
}
__device__ __forceinline__ void tr_item2(const float* W, int ldw, int srccol  , const float* g, int K, int k0, int n0, bf16* WT, LAS float* scr, int lane) {
    float t[32];
    const float* colp = W + (size_t)(k0 + (lane >> 5)) * ldw + (srccol < 0 ? 0 : srccol);
#pragma unroll
    for (int i = 0; i < 32; ++i) t[i] = colp[(size_t)(2 * i) * ldw];
    const float zf = srccol < 0 ? 0.f : 1.f;
#pragma unroll
    for (int i = 0; i < 32; ++i) scr[(2 * i + (lane >> 5)) * 33 + (lane & 31)] = t[i] * zf;
    const int c = lane & 7;
    f32x4 ga = {1.f, 1.f, 1.f, 1.f}, gb = {1.f, 1.f, 1.f, 1.f};
    if (g) { ga = *(const f32x4*)(g + k0 + 8 * c); gb = *(const f32x4*)(g + k0 + 8 * c + 4); }
    LDS_WAIT(); asm volatile("" ::: "memory");
#pragma unroll
    for (int j = 0; j < 4; ++j) { const int n = (lane >> 3) + 8 * j; const LAS float* sp = scr + (8 * c) * 33 + n;
        v4u o; o.x = pk2(sp[0 * 33] * ga.x, sp[1 * 33] * ga.y); o.y = pk2(sp[2 * 33] * ga.z, sp[3 * 33] * ga.w); o.z = pk2(sp[4 * 33] * gb.x, sp[5 * 33] * gb.y); o.w = pk2(sp[6 * 33] * gb.z, sp[7 * 33] * gb.w);
        *(v4u*)(WT + (size_t)(n0 + n) * K + k0 + 8 * c) = o; }
    LDS_WAIT(); asm volatile("" ::: "memory");
}

namespace pg8 {
struct FlexOrder : StaticOrder {
    int panel, ppm, member;
    __device__ __forceinline__ bool next(int i, Unit& u) const {
        if (panel) { const int pn = member + 4 * i; if (pn >= nN) return false; u.pm = ppm; u.pn = pn; return true; }
        return StaticOrder::next(i, u);
    }
};
}
__device__ __forceinline__ void group_barrier(unsigned* cnt, bool same_l2) {
    asm volatile("s_waitcnt vmcnt(0)" ::: "memory");
    __syncthreads();
    if (threadIdx.x == 0) {
        if (!same_l2) __builtin_amdgcn_fence(__ATOMIC_RELEASE, "agent");
        asm volatile("s_waitcnt vmcnt(0)" ::: "memory");
        __hip_atomic_fetch_add(cnt, 1u, __ATOMIC_RELAXED, __HIP_MEMORY_SCOPE_AGENT);
        unsigned sp = 0u;
        while (__hip_atomic_load(cnt, __ATOMIC_RELAXED, __HIP_MEMORY_SCOPE_AGENT) < 4u) { __builtin_amdgcn_s_sleep(1); if (++sp > (1u << 22)) break; }
        __builtin_amdgcn_fence(__ATOMIC_ACQUIRE, "agent");
        asm volatile("s_waitcnt vmcnt(0)" ::: "memory");
    }
    __syncthreads();
}
#ifndef PROBE_PH
#define PROBE_PH -1
#endif
struct Args { const float* in[17]; float* out; unsigned char* ws; int ph_lo, ph_hi; };

__global__ void __launch_bounds__(NWAVES * 64, 2) yoco_fwd(Args args) {
    extern __shared__ __attribute__((aligned(16))) unsigned char lds[];
    cg::grid_group grid = cg::this_grid();
#define TID_INIT() int tid_ = threadIdx.x; asm volatile("" : "+v"(tid_)); const int tid = tid_, lane = tid & 63, wave = __builtin_amdgcn_readfirstlane(tid >> 6); const int gw = vcu * NWAVES + wave; (void)lane; (void)gw
    const int G = gridDim.x, bx = blockIdx.x;
    for (int u_ = threadIdx.x; u_ < (LDS_BYTES - 131072) / 4; u_ += NWAVES * 64) ((LAS unsigned*)(lds + 131072))[u_] = 0u;
    __syncthreads();
    const XcdBarrier xbar = xcd_barrier_post((unsigned*)(args.ws + WS_CTL) + 4096, (volatile LAS unsigned*)(lds + 131072 + 320) + 8);
    const bool panel_mode = (G == 256);
    const int g_pm = 8 * (bx & 7) + ((bx >> 3) & 7), g_mem = bx >> 6;
    unsigned* const gctl = (unsigned*)(args.ws + WS_CTL + 576 * 1024);
    if (panel_mode && threadIdx.x == 0) __hip_atomic_store(gctl + bx, xb_xcc_id() + 1u, __ATOMIC_RELAXED, __HIP_MEMORY_SCOPE_AGENT);
    bool same_l2 = false;
    const int vcu = (G % 8 == 0) ? (bx % 8) * (G / 8) + bx / 8 : bx;
#define ws (args.ws)
#define x_in (args.in[0])
#define g_mix (args.in[1])
#define g_ffn (args.in[2])
#define w_fin (args.in[3])
#define b_f (args.in[4])
#define w_fout (args.in[5])
#define g_kv (args.in[6])
#define w_kva (args.in[7])
#define g_kva (args.in[8])
#define w_kvb (args.in[9])
#define w_qa (args.in[10])
#define g_qa (args.in[11])
#define w_qb (args.in[12])
#define w_mout (args.in[13])
#define w_up (args.in[14])
#define w_dn (args.in[15])
#define g_fin (args.in[16])
#define out (args.out)
#define ssb ((float*)(ws + WS_CTL))
#define SS(i) (ssb + (size_t)(i) * SS_WORDS)
#define rope ((float*)(ws + WS_ROPE))
#define lf ((float*)(ws + WS_LF))
#define cc ((double*)(ws + WS_C))
#define XB ((bf16*)(ws + WS_XB))
#define FQB ((bf16*)out)
#define FKB ((bf16*)out + (size_t)M * 1024)
#define FVB ((bf16*)(ws + WS_MO))
#define CKVB ((bf16*)out)
#define QAB ((bf16*)out + (size_t)M * 256)
#ifndef STREAM_LO
#define STREAM_LO 0
#endif
#define LOB (STREAM_LO ? (bf16*)out : (bf16*)nullptr)
#define HB ((bf16*)(ws + WS_H))
    const int lo = args.ph_lo, hi_ph = args.ph_hi;
#ifndef PHMASK
#define PHMASK 0xffffffffu
#endif
#define IN(k) (((PHMASK >> (k)) & 1u) && lo <= (k) && (k) < hi_ph)
#define SEAM(k) do { if (IN(k) && IN((k) + 1)) { if (args.ph_lo < 0) grid.sync();   xcd_barrier(xbar); } } while (0)
    const int NGW = G * NWAVES;
#define GSEAM(k) do { if (IN(k) && IN((k) + 1)) { if (panel_mode) group_barrier(gctl + 1024 + ((k) * 64 + g_pm) * 16, same_l2); else xcd_barrier(xbar); } } while (0)
#define FLEX(S, N_) pg8::FlexOrder S; S.init(M, (N_), G, bx); S.panel = panel_mode ? 1 : 0; S.ppm = g_pm; S.member = g_mem

    if (IN(0)) for (int rep_ = 0; rep_ < (PROBE_PH == 0 ? 2 : 1); ++rep_) { TID_INIT();
        LAS float* gwl = (LAS float*)lds;
        for (int i = tid; i < 4 * 1024; i += NWAVES * 64) { const int k = i >> 2, h4 = (i & 3) * 4; const f32x4 w4 = *(const f32x4*)(w_fin + (size_t)k * 3088 + 3072 + h4); const float gk = g_mix[k];
            gwl[(h4 + 0) * 1024 + k] = w4.x * gk; gwl[(h4 + 1) * 1024 + k] = w4.y * gk; gwl[(h4 + 2) * 1024 + k] = w4.z * gk; gwl[(h4 + 3) * 1024 + k] = w4.w * gk; }
        __syncthreads();
        {
            f32x4 v[4], vn[4];
            const int NRW = NGW;
            int m = gw;
            if (m < M) { const f32x4* xr = (const f32x4*)(x_in + (size_t)m * D) + lane;
#pragma unroll
                for (int j = 0; j < 4; ++j) v[j] = xr[64 * j]; }
            for (; m < M; m += NRW) {
                const int mn = m + NRW;
                if (mn < M) { const f32x4* xr = (const f32x4*)(x_in + (size_t)mn * D) + lane;
#pragma unroll
                    for (int j = 0; j < 4; ++j) vn[j] = xr[64 * j]; }
                float s = 0.f;
#pragma unroll
                for (int j = 0; j < 4; ++j) s += (v[j].x * v[j].x + v[j].y * v[j].y) + (v[j].z * v[j].z + v[j].w * v[j].w);
                s = wave_sum(s);
                if (lane == 0) SS(SS0)[m] = s;
                unsigned long long* o8 = (unsigned long long*)(XB + (size_t)m * D) + lane;
#pragma unroll
                for (int j = 0; j < 4; ++j) o8[64 * j] = (unsigned long long)pk2(v[j].x, v[j].y) | ((unsigned long long)pk2(v[j].z, v[j].w) << 32);
                const float rstd = rsqrtf(s * (1.f / D) + RMS_EPS);
                float acc[16];
#pragma unroll
                for (int h = 0; h < 16; ++h) { float d = 0.f;
#pragma unroll
                    for (int j = 0; j < 4; ++j) { const f32x4 w = *(const LAS f32x4*)(gwl + h * 1024 + 256 * j + 4 * lane); d += (v[j].x * w.x + v[j].y * w.y) + (v[j].z * w.z + v[j].w * w.w); }
                    acc[h] = d; if ((h & 3) == 3) asm volatile("" ::: "memory"); }
#pragma unroll
                for (int i = 0; i < 8; ++i) { const bool up = (lane & 32) != 0; const float keep = up ? acc[i + 8] : acc[i], send = up ? acc[i] : acc[i + 8]; acc[i] = keep + __shfl_xor(send, 32); }
#pragma unroll
                for (int i = 0; i < 4; ++i) { const bool up = (lane & 16) != 0; const float keep = up ? acc[i + 4] : acc[i], send = up ? acc[i] : acc[i + 4]; acc[i] = keep + __shfl_xor(send, 16); }
#pragma unroll
                for (int i = 0; i < 2; ++i) { const bool up = (lane & 8) != 0; const float keep = up ? acc[i + 2] : acc[i], send = up ? acc[i] : acc[i + 2]; acc[i] = keep + __shfl_xor(send, 8); }
                { const bool up = (lane & 4) != 0; const float keep = up ? acc[1] : acc[0], send = up ? acc[0] : acc[1]; acc[0] = keep + __shfl_xor(send, 4); }
                acc[0] += __shfl_xor(acc[0], 2); acc[0] += __shfl_xor(acc[0], 1);
                if ((lane & 3) == 0) { const int h = ((lane >> 5) & 1) * 8 + ((lane >> 4) & 1) * 4 + ((lane >> 3) & 1) * 2 + ((lane >> 2) & 1);
                    const float z = acc[0] * rstd + b_f[h]; const float ls = fminf(z, 0.f) - log1pf(expf(-fabsf(z)));
                    lf[(size_t)((m >> 13) * 16 + h) * SEQ + (m & (SEQ - 1))] = ls; }
#pragma unroll
                for (int j = 0; j < 4; ++j) v[j] = vn[j];
            }
        }
        for (int idx = bx * (NWAVES * 64) + tid; idx < SEQ * 32; idx += G * NWAVES * 64) { const int pos = idx >> 5, i = idx & 31;
            const float inv = exp2f(-(float)i * (13.287712379549449f / 32.f)); const float ang = (float)pos * inv;
            double rv = (double)ang * 0.15915494309189535; rv -= __builtin_rint(rv); const float fr = (float)rv;
            rope[2 * idx] = __builtin_amdgcn_cosf(fr); rope[2 * idx + 1] = __builtin_amdgcn_sinf(fr); }
        __syncthreads();
        LAS float* scr = (LAS float*)(lds + wave * 16384);
        constexpr int I0 = 16 * 96, I1 = 16 * 32, I2 = 16 * 24, I3 = 4 * 64, I4 = 6 * 48, I5 = 16 * 32, I6 = 16 * 128, I8 = 64 * 32;
        constexpr int NIT = I0 + I1 + I2 + I3 + I4 + I5 + 2 * I6 + 2 * I8;
        for (int it = gw; it < NIT; it += NGW) { int r = it; const int nl = lane & 31;
#define TR_PLAIN(Wp, ldw_, gp, K_, nblk_, dst_) do { const int k0_ = 64 * (r / (nblk_)), n0_ = 32 * (r % (nblk_)); tr_item2((Wp), (ldw_), n0_ + nl, (gp), (K_), k0_, n0_, (bf16*)(ws + (dst_)), scr, lane); } while (0)
            if (r < I0) { TR_PLAIN(w_fin, 3088, g_mix, 1024, 96, W_FIN); continue; } r -= I0;
            if (r < I1) { TR_PLAIN(w_fout, 1024, nullptr, 1024, 32, W_FOUT); continue; } r -= I1;
            if (r < I2) { const int k0_ = 64 * (r / 24), n0_ = 32 * (r % 24), n_ = n0_ + nl;
                if (n0_ < 256) tr_item2(w_kva, 320, n_, g_kv, 1024, k0_, n0_, (bf16*)(ws + W_QKVA), scr, lane);
                else if (n0_ < 640) tr_item2(w_qa, 384, n_ - 256, g_mix + D, 1024, k0_, n0_, (bf16*)(ws + W_QKVA), scr, lane);
                else if (n0_ < 704) { const int c2 = n_ - 640; tr_item2(w_kva, 320, 256 + (c2 >> 1) + 32 * (c2 & 1), g_kv, 1024, k0_, n0_, (bf16*)(ws + W_QKVA), scr, lane); }
                else tr_item2(w_kva, 320, -1, nullptr, 1024, k0_, n0_, (bf16*)(ws + W_QKVA), scr, lane);
                continue; } r -= I2;
            if (r < I3) { TR_PLAIN(w_kvb, 2048, g_kva, 256, 64, W_KVB); continue; } r -= I3;
            if (r < I4) { const int k0_ = 64 * (r / 48), n0_ = 32 * (r % 48), n_ = n0_ + nl; int src;
                if (n_ < 1024) src = (n_ >> 7) * 192 + (n_ & 127); else { const int q_ = n_ - 1024; src = (q_ >> 6) * 192 + 128 + ((q_ & 63) >> 1) + 32 * (q_ & 1); }
                tr_item2(w_qb, 1536, src, g_qa, 384, k0_, n0_, (bf16*)(ws + W_QB), scr, lane); continue; } r -= I4;
            if (r < I5) { if (!panel_mode) TR_PLAIN(w_mout, 1024, nullptr, 1024, 32, W_MOUT); continue; } r -= I5;
            if (r < I6) { TR_PLAIN(w_up, 4096, g_ffn, 1024, 128, W_UP0); continue; } r -= I6;
            if (r < I6) { if (!panel_mode) TR_PLAIN(w_up + (size_t)D * FF, 4096, g_ffn + D, 1024, 128, W_UP1); continue; } r -= I6;
            if (r < I8) { TR_PLAIN(w_dn, 1024, nullptr, 4096, 32, W_DN0); continue; } r -= I8;
            if (!panel_mode) TR_PLAIN(w_dn + (size_t)FF * D, 1024, nullptr, 4096, 32, W_DN1);
        }
        __syncthreads();
    }
    SEAM(0);
    if (IN(1)) for (int rep_ = 0; rep_ < (PROBE_PH == 1 ? 2 : 1); ++rep_) { TID_INIT();
        LAS double* red = (LAS double*)lds;
        for (int w = bx; w < 256; w += G) { const int bh = w >> 3, ch = w & 7; const float* src = lf + (size_t)bh * SEQ;
            double p = 0.0; { float pv_[14];
#pragma unroll
                for (int k = 0; k < 14; ++k) { const int i = tid + k * (NWAVES * 64); pv_[k] = i < ch * 1024 ? src[i] : 0.f; }
#pragma unroll
                for (int k = 0; k < 14; ++k) p += (double)pv_[k]; }
            p = wave_sum_d(p); if (lane == 0) red[wave] = p;
            __syncthreads();
            double pre = 0.0;
#pragma unroll
            for (int k = 0; k < 8; ++k) pre += red[k];
            const float a = src[ch * 1024 + 2 * tid], b = src[ch * 1024 + 2 * tid + 1]; const double s2 = (double)a + (double)b;
            double inc = s2;
#pragma unroll
            for (int o = 1; o < 64; o <<= 1) { const int thi = __shfl_up(__double2hiint(inc), o), tlo = __shfl_up(__double2loint(inc), o); if (lane >= o) inc += __hiloint2double(thi, tlo); }
            if (lane == 63) red[8 + wave] = inc;
            __syncthreads();
            double woff = 0.0;
#pragma unroll
            for (int k = 0; k < 8; ++k) if (k < wave) woff += red[8 + k];
            const double excl = pre + woff + inc - s2;
            cc[(size_t)bh * SEQ + ch * 1024 + 2 * tid] = excl + (double)a; cc[(size_t)bh * SEQ + ch * 1024 + 2 * tid + 1] = excl + s2;
            __syncthreads();
        }
        pg8::Gemm g{XB, (const bf16*)(ws + W_FIN), M, 3072, 1024}; pg8::StaticOrder S; S.init(M, 3072, G, bx);
        pg8::EpiQKV E{FQB, (size_t)M * 1024, FVB, SS(SS0), C2_FOX, (unsigned*)(ws + WS_CTL + 512 * 1024)};
        pg8::gemm_phase<pg8::EpiQKV, pg8::StaticOrder, true, true>((LAS unsigned char*)lds, g, S, E);
    }
    SEAM(1);
    if (panel_mode) {
        if (threadIdx.x == 0) { const unsigned mine = __hip_atomic_load(gctl + bx, __ATOMIC_RELAXED, __HIP_MEMORY_SCOPE_AGENT); unsigned same = 1u;
#pragma unroll
            for (int m_ = 0; m_ < 4; ++m_) same &= (__hip_atomic_load(gctl + 8 * ((g_pm & 7) + 8 * m_) + (g_pm >> 3), __ATOMIC_RELAXED, __HIP_MEMORY_SCOPE_AGENT) == mine) ? 1u : 0u;
            ((LAS unsigned*)(lds + 131072))[16] = same; }
        __syncthreads();
        same_l2 = ((LAS unsigned*)(lds + 131072))[16] != 0u;
    }
    if (IN(2)) {
        for (int i = 0, idx = vcu; panel_mode ? i < 4 : idx < 1024; ++i, idx += G) { int bh, qb;
            if (panel_mode) { bh = (g_pm >> 5) * 16 + 4 * g_mem + i; qb = g_pm & 31; }
            else { const int k4 = idx >> 8, v = idx & 255, s_ = v & 7; bh = v >> 3; qb = (k4 == 0) ? s_ : (k4 == 1) ? 15 - s_ : (k4 == 2) ? 16 + s_ : 31 - s_; }
            const int b = bh >> 4, h = bh & 15;
            att::Unit U; const size_t ro = (size_t)b * SEQ * 1024 + h * 64;
            U.q[0] = FQB + ro; U.q[1] = U.q[0]; U.qs = 1024;
            U.kA = FKB + ro; U.ksA = 1024; U.kB = U.kA; U.ksB = 1024;
            U.v = FVB + ro; U.vs = 1024;
            U.o = FQB + ro; U.os = 1024; U.c = cc + (size_t)bh * SEQ; U.rtab = nullptr; U.kmax2 = (const unsigned*)(ws + WS_CTL + 512 * 1024) + bh * 2; U.q0 = qb * 256; U.j_lo = 0;
            att::attn_unit<64, 64, true>(U, (char*)lds);
        }
    }
    GSEAM(2);
    if (IN(3)) {
        pg8::Gemm g{FQB, (const bf16*)(ws + W_FOUT), M, 1024, 1024}; FLEX(S, 1024);
        pg8::EpiRes E{STREAM_LO ? x_in : (const float*)nullptr, XB, LOB, SS(SS1)};
        pg8::gemm_phase<pg8::EpiRes, pg8::FlexOrder, true, true>((LAS unsigned char*)lds, g, S, E);
    }
    GSEAM(3);
    if (IN(4)) for (int rep_ = 0; rep_ < (PROBE_PH == 4 ? 2 : 1); ++rep_) {
        pg8::Gemm g{XB, (const bf16*)(ws + W_UP0), M, 4096, 1024}; FLEX(S, 4096);
        pg8::EpiUp E{HB, SS(SS1)};
        pg8::gemm_phase<pg8::EpiUp, pg8::FlexOrder, true, true>((LAS unsigned char*)lds, g, S, E);
    }
    GSEAM(4);
    if (IN(5)) {
        pg8::Gemm g{HB, (const bf16*)(ws + W_DN0), M, 1024, 4096}; FLEX(S, 1024);
        pg8::EpiRes E{nullptr, XB, LOB, SS(SS2)};
        pg8::gemm_phase<pg8::EpiRes, pg8::FlexOrder, true, true>((LAS unsigned char*)lds, g, S, E);
    }
    GSEAM(5);
    if (IN(6) && panel_mode) {
        if (threadIdx.x == 0) { const int dep[3] = {g_pm >> 2, (4096 + 96 * g_pm) >> 8, (4096 + 96 * g_pm + 95) >> 8};
#pragma unroll
            for (int d_ = 0; d_ < 3; ++d_) { const unsigned* c_ = gctl + 1024 + (3 * 64 + dep[d_]) * 16; unsigned sp = 0u;
                while (__hip_atomic_load(c_, __ATOMIC_RELAXED, __HIP_MEMORY_SCOPE_AGENT) < 4u) { __builtin_amdgcn_s_sleep(1); if (++sp > (1u << 22)) break; } } }
        __syncthreads();
    }
    if (IN(6)) {
        if (panel_mode && g_mem == 3) { TID_INIT();
            LAS float* scr = (LAS float*)(lds + wave * 16384); const int nl = lane & 31;
            for (int it = g_pm * NWAVES + wave; it < 512 + 2048 + 2048; it += 64 * NWAVES) { int r = it;
                if (r < 512) { TR_PLAIN(w_mout, 1024, nullptr, 1024, 32, W_MOUT); continue; } r -= 512;
                if (r < 2048) { TR_PLAIN(w_up + (size_t)D * FF, 4096, g_ffn + D, 1024, 128, W_UP1); continue; } r -= 2048;
                TR_PLAIN(w_dn + (size_t)FF * D, 1024, nullptr, 4096, 32, W_DN1); }
            __syncthreads();
        }
        pg8::Gemm g{XB, (const bf16*)(ws + W_QKVA), M, 768, 1024}; FLEX(S, 768);
        pg8::EpiQKVA E{CKVB, QAB, (bf16*)(ws + WS_MKR), SS(SS2), SS(SSKV), SS(SSQ), rope};
        pg8::gemm_phase<pg8::EpiQKVA, pg8::FlexOrder, true, true>((LAS unsigned char*)lds, g, S, E);
    }
    GSEAM(6);
    if (IN(7) && panel_mode) {
        if (threadIdx.x == 0) { const int dep[3] = {g_pm >> 1, (256 + 3 * g_pm) >> 3, (258 + 3 * g_pm) >> 3};
#pragma unroll
            for (int d_ = 0; d_ < 3; ++d_) { const unsigned* c_ = gctl + 1024 + (5 * 64 + dep[d_]) * 16; unsigned sp = 0u;
                while (__hip_atomic_load(c_, __ATOMIC_RELAXED, __HIP_MEMORY_SCOPE_AGENT) < 4u) { __builtin_amdgcn_s_sleep(1); if (++sp > (1u << 22)) break; } } }
        __syncthreads();
    }
    if (IN(7)) for (int rep_ = 0; rep_ < (PROBE_PH == 7 ? 2 : 1); ++rep_) {
        { pg8::Gemm g{CKVB, (const bf16*)(ws + W_KVB), M, 2048, 256}; FLEX(S, 2048);
          pg8::EpiKVB E{(bf16*)(ws + WS_MKV), SS(SSKV)};
          pg8::gemm_phase<pg8::EpiKVB, pg8::FlexOrder, true, true>((LAS unsigned char*)lds, g, S, E); }
        { pg8::Gemm g{QAB, (const bf16*)(ws + W_QB), M, 1536, 384}; FLEX(S, 1536);
          pg8::EpiQB E{(bf16*)(ws + WS_MQ), SS(SSQ), C2_MLA};
          pg8::gemm_phase<pg8::EpiQB, pg8::FlexOrder, false, true>((LAS unsigned char*)lds, g, S, E); }
    }
    SEAM(7);
    if (IN(8)) for (int rep_ = 0; rep_ < (PROBE_PH == 8 ? 2 : 1); ++rep_) {
        for (int i = vcu; i < 512; i += G) { const int k2 = i >> 8, v = i & 255, bh = v >> 4, s = v & 15, b = bh >> 3, h = bh & 7;
            const int qb = (k2 == 0) ? 31 - s : s;
            att::Unit U; const size_t rq = (size_t)b * SEQ * 1536, rk = (size_t)b * SEQ * 2048;
            U.q[0] = (const bf16*)(ws + WS_MQ) + rq + h * 128; U.q[1] = (const bf16*)(ws + WS_MQ) + rq + 1024 + h * 64; U.qs = 1536;
            U.kA = (const bf16*)(ws + WS_MKV) + rk + h * 256; U.ksA = 2048; U.kB = (const bf16*)(ws + WS_MKR) + (size_t)b * SEQ * 64; U.ksB = 64;
            U.v = (const bf16*)(ws + WS_MKV) + rk + h * 256 + 128; U.vs = 2048;
            U.o = (bf16*)(ws + WS_MO) + (size_t)b * SEQ * 1024 + h * 128; U.os = 1024; U.c = nullptr; U.kmax2 = nullptr; U.rtab = rope; U.q0 = qb * 256; U.j_lo = 0;
            att::attn_unit<192, 128, false>(U, (char*)lds);
        }
    }
    SEAM(8);
    if (IN(9)) {
        pg8::Gemm g{(const bf16*)(ws + WS_MO), (const bf16*)(ws + W_MOUT), M, 1024, 1024}; FLEX(S, 1024);
        pg8::EpiRes E{nullptr, XB, LOB, SS(SS3)};
        pg8::gemm_phase<pg8::EpiRes, pg8::FlexOrder, true, true>((LAS unsigned char*)lds, g, S, E);
    }
    GSEAM(9);
    if (IN(10)) {
        pg8::Gemm g{XB, (const bf16*)(ws + W_UP1), M, 4096, 1024}; FLEX(S, 4096);
        pg8::EpiUp E{HB, SS(SS3)};
        pg8::gemm_phase<pg8::EpiUp, pg8::FlexOrder, true, true>((LAS unsigned char*)lds, g, S, E);
    }
    GSEAM(10);
    if (IN(11)) {
        pg8::Gemm g{HB, (const bf16*)(ws + W_DN1), M, 1024, 4096}; FLEX(S, 1024);
        if (G == 256) {
            pg8::EpiResFinal E{XB, LOB, out, SS(SS4), g_fin, (unsigned*)(ws + WS_CTL + 40960)};
            pg8::gemm_phase<pg8::EpiResFinal, pg8::FlexOrder, false, true>((LAS unsigned char*)lds, g, S, E);
        } else {
            pg8::EpiRes E{nullptr, XB, LOB, SS(SS4)};
            pg8::gemm_phase<pg8::EpiRes, pg8::FlexOrder, true, true>((LAS unsigned char*)lds, g, S, E);
            xcd_barrier(xbar);
            TID_INIT();
            if (wave == 0) for (int pm_ = bx; pm_ < M / 256; pm_ += G) for (int rr = 255; rr >= 0; --rr) { const int m = pm_ * 256 + rr;
                const float rstd = rsqrtf(SS(SS4)[m] * (1.f / D) + RMS_EPS); f32x4 v[4];
#pragma unroll
                for (int j = 0; j < 4; ++j) { const size_t e = (size_t)m * D + 256 * j + 4 * lane; const unsigned long long hw = *(const unsigned long long*)(XB + e), lw = STREAM_LO ? *(const unsigned long long*)((const bf16*)out + (size_t)pm_ * 262144 + e) : 0ull;
                    v[j].x = __uint_as_float((unsigned)hw << 16) + __uint_as_float((unsigned)lw << 16); v[j].y = __uint_as_float((unsigned)hw & 0xffff0000u) + __uint_as_float((unsigned)lw & 0xffff0000u);
                    v[j].z = __uint_as_float((unsigned)(hw >> 32) << 16) + __uint_as_float((unsigned)(lw >> 32) << 16); v[j].w = __uint_as_float((unsigned)(hw >> 32) & 0xffff0000u) + __uint_as_float((unsigned)(lw >> 32) & 0xffff0000u); }
                asm volatile("s_waitcnt vmcnt(0)" ::: "memory");
#pragma unroll
                for (int j = 0; j < 4; ++j) *((f32x4*)(out + (size_t)m * D) + 64 * j + lane) = v[j] * rstd * *((const f32x4*)g_fin + 64 * j + lane);
                asm volatile("s_waitcnt vmcnt(0)" ::: "memory"); }
        }
    }
#undef TR_PLAIN
#undef IN
#undef SEAM
#undef GSEAM
#undef FLEX
#undef SS
#undef x_in
#undef g_mix
#undef g_ffn
#undef w_fin
#undef b_f
#undef w_fout
#undef g_kv
#undef w_kva
#undef g_kva
#undef w_kvb
#undef w_qa
#undef g_qa
#undef w_qb
#undef w_mout
#undef w_up
#undef w_dn
#undef g_fin
#undef out
#undef ws
#undef rope
#undef lf
#undef cc
#undef XB
#undef FQB
#undef FKB
#undef FVB
#undef CKVB
#undef QAB
#undef LOB
#undef HB
#undef ssb
}

constexpr int N_PHASES = 12;
#ifndef MK_PER_PHASE
#define MK_PER_PHASE 0
#endif
extern "C" void kernel_launch(void* const* d_in, const int* in_sizes, int n_in, void* d_out, int out_size, void* d_ws, size_t ws_size, hipStream_t stream) {
    static int grid = 0;
    if (grid == 0) {
        if (n_in != 17 || in_sizes[0] != M * D || out_size != M * D || ws_size < WS_END) { fprintf(stderr, "kernel_launch: unexpected shapes (n_in %d, in0 %d, out %d, ws %zu)\n", n_in, n_in > 0 ? in_sizes[0] : -1, out_size, ws_size); grid = -1; return; }
        int dev = 0, cus = 0, per_cu = 0;
        if (hipGetDevice(&dev) != hipSuccess || hipDeviceGetAttribute(&cus, hipDeviceAttributeMultiprocessorCount, dev) != hipSuccess) { grid = -1; return; }
        if (hipFuncSetAttribute((const void*)yoco_fwd, hipFuncAttributeMaxDynamicSharedMemorySize, LDS_BYTES) != hipSuccess) { fprintf(stderr, "kernel_launch: hipFuncSetAttribute failed\n"); grid = -1; return; }
        if (hipOccupancyMaxActiveBlocksPerMultiprocessor(&per_cu, (const void*)yoco_fwd, NWAVES * 64, LDS_BYTES) != hipSuccess || per_cu < 1) { fprintf(stderr, "kernel_launch: occupancy query says %d\n", per_cu); per_cu = 1; }
        (void)hipGetLastError();
        grid = cus * per_cu;
    }
    if (grid < 0) return;
    (void)hipMemsetAsync((char*)d_ws + WS_CTL, 0, CTL_ZERO_BYTES, stream);
    Args a{};
    for (int i = 0; i < 17; ++i) a.in[i] = (const float*)d_in[i];
    a.out = (float*)d_out; a.ws = (unsigned char*)d_ws;
#if MK_PER_PHASE
    for (int p = 0; p < N_PHASES; ++p) { a.ph_lo = p; a.ph_hi = p + 1; hipLaunchKernelGGL(yoco_fwd, dim3(grid), dim3(NWAVES * 64), LDS_BYTES, stream, a); }
#else
    a.ph_lo = 0; a.ph_hi = N_PHASES;
    void* kargs[] = {&a};
    hipError_t e = hipLaunchCooperativeKernel((const void*)yoco_fwd, dim3(grid), dim3(NWAVES * 64), kargs, LDS_BYTES, stream);
    if (e != hipSuccess) fprintf(stderr, "kernel_launch: cooperative launch failed: %s (grid %d)\n", hipGetErrorString(e), grid);
#endif
}
```

```cpp
#include <hip/hip_runtime.h>
#include <hip/hip_cooperative_groups.h>
#include <cstdio>
#include <cstdint>
namespace cg = cooperative_groups;
namespace pg8 {
#define PG8_LAS __attribute__((address_space(3)))
typedef unsigned short bf16_t;
typedef short bf16x8 __attribute__((ext_vector_type(8)));
typedef float f32x4 __attribute__((ext_vector_type(4)));
typedef unsigned u32x4 __attribute__((ext_vector_type(4)));
constexpr int BM = 256, BK = 64, HALF = 128, HTB = HALF * BK * 2  , STAGE_BYTES = 8 * HTB, NXCD = 8, WGM = 8;

__host__ __device__ __forceinline__ int lds_byte(int r, int c) { const int st = (r >> 4) * 2 + (c >> 5), rr = r & 15, cc = c & 31, ob = rr * 64 + cc * 2; return st * 1024 + (ob ^ (((ob >> 9) & 1) << 5)); }
__host__ __device__ __forceinline__ void stage_rc(int b, int& R, int& C) { const int st = b / 1024, sb = b % 1024, swz = sb ^ (((sb >> 9) & 1) << 5); R = (st >> 1) * 16 + swz / 64; C = (st & 1) * 32 + (swz % 64) / 2; }
__host__ __device__ __forceinline__ int perm32(int rho) { const int n = rho >> 4, i = rho & 15; return 8 * (i >> 2) + 4 * n + (i & 3); }

struct Unit { int pm, pn; };
struct Gemm { const bf16_t* A; const bf16_t* Bt; int M, N, K; };

struct StaticOrder {
    int nM, nN, nwg, G, c;
    __host__ __device__ void init(int M, int N, int G_, int c_) { nM = M / BM; nN = N / BM; nwg = nM * nN; G = G_; c = c_; }
    __host__ __device__ bool next(int i, Unit& u) const {
        const long L = (long)i * G + c; if (L >= nwg) return false;
        int wgid = (int)L; { const int q = nwg / NXCD, r = nwg % NXCD, xcd = wgid % NXCD, off = wgid / NXCD; wgid = (xcd < r ? xcd * (q + 1) : r * (q + 1) + (xcd - r) * q) + off; }
        const int nig = WGM * nN, gid = wgid / nig, fm = gid * WGM, gsz = (nM - fm) < WGM ? (nM - fm) : WGM;
        u.pm = fm + ((wgid % nig) % gsz); u.pn = (wgid % nig) / gsz; return true;
    }
    __device__ __forceinline__ void a_ready(const Unit&) const {}
    __device__ __forceinline__ void done(const Unit&) const {}
};

__device__ __forceinline__ unsigned cvt_pk_bf16(float lo, float hi) { unsigned r; asm volatile("v_cvt_pk_bf16_f32 %0, %1, %2" : "=v"(r) : "v"(lo), "v"(hi)); return r; }
typedef float f32x2 __attribute__((ext_vector_type(2)));
template <class Epi, class Sched, bool ALIGN_EPI = false, bool SP2 = false>
__device__ __forceinline__ void gemm_phase(PG8_LAS unsigned char* lds, const Gemm g, const Sched& S, const Epi& E) {
    int tid_ = threadIdx.x; asm volatile("" : "+v"(tid_));
    const int tid = tid_, wid = __builtin_amdgcn_readfirstlane(tid >> 6), lane = tid & 63, wr = wid >> 2, wc = wid & 3, fr = lane & 15, fq = lane >> 4;
    const int K = g.K, nt = K / BK;
    unsigned voffA[2], voffB[2];
#pragma unroll
    for (int i = 0; i < 2; ++i) { int R, C; stage_rc(tid * 16 + i * 8192, R, C); const int Rb = Epi::PERM ? ((R & ~31) + perm32(R & 31)) : R;
        voffA[i] = (unsigned)(R * K + C) * 2u; voffB[i] = (unsigned)(Rb * K + C) * 2u; }
    const size_t kstep = (size_t)(BK * 2);
    const size_t hstep = (size_t)HALF * K * 2;
    const size_t tstep = 2 * hstep;
    const unsigned ldsw = (unsigned)wid * 1024u;
    const int aoff = lds_byte(wr * 64 + fr, fq * 8), boff = lds_byte(wc * 32 + fr, fq * 8);
#define PG8_SA(b, h) (((b) * 2 + (h)) * HTB)
#define PG8_SB(b, h) ((4 + (b) * 2 + (h)) * HTB)
#define PG8_STAGE(bufoff, gbase, voff) do { _Pragma("unroll") for (int _i = 0; _i < 2; ++_i) \
        __builtin_amdgcn_global_load_lds((const unsigned*)((const char*)(gbase) + (voff)[_i]), (PG8_LAS unsigned*)(lds + (bufoff) + ldsw + _i * 8192), 16, 0, 0); } while (0)
#define PG8_LDA(dst, b, h) do { _Pragma("unroll") for (int m = 0; m < 4; ++m) _Pragma("unroll") for (int k = 0; k < 2; ++k) dst[m][k] = *(const PG8_LAS bf16x8*)(lds + PG8_SA(b, h) + aoff + m * 2048 + k * 1024); } while (0)
#define PG8_LDB(dst, b, h) do { _Pragma("unroll") for (int n = 0; n < 2; ++n) _Pragma("unroll") for (int k = 0; k < 2; ++k) dst[n][k] = *(const PG8_LAS bf16x8*)(lds + PG8_SB(b, h) + boff + n * 2048 + k * 1024); } while (0)
#define PG8_MMA(ai, bj, At, Bt) do { __builtin_amdgcn_s_setprio(1); _Pragma("unroll") for (int m = 0; m < 4; ++m) _Pragma("unroll") for (int n = 0; n < 2; ++n) _Pragma("unroll") for (int k = 0; k < 2; ++k) \
        acc[ai][bj][m][n] = __builtin_amdgcn_mfma_f32_16x16x32_bf16(Bt[n][k], At[m][k], acc[ai][bj][m][n], 0, 0, 0); __builtin_amdgcn_s_setprio(0); } while (0)
#define PG8_WAIT_V(n) asm volatile("s_waitcnt vmcnt(" #n ")" ::: "memory")
#define PG8_WAIT_L(n) asm volatile("s_waitcnt lgkmcnt(" #n ")" ::: "memory")
#define PG8_BAR __builtin_amdgcn_s_barrier()
#define PG8_SCHED __builtin_amdgcn_sched_barrier(0)
    Unit cur, nxt; int ui = 0;
    if (!S.next(0, cur)) return;
    f32x4 acc[2][2][4][2];
#pragma unroll
    for (int a = 0; a < 2; ++a)
#pragma unroll
        for (int b = 0; b < 2; ++b)
#pragma unroll
            for (int m = 0; m < 4; ++m)
#pragma unroll
                for (int n = 0; n < 2; ++n) acc[a][b][m][n] = (f32x4){0.f, 0.f, 0.f, 0.f};
    bf16x8 At[4][2], B0[2][2], B1[2][2];
    const char* cA = (const char*)g.A + (size_t)cur.pm * tstep; const char* cB = (const char*)g.Bt + (size_t)cur.pn * tstep;
    if constexpr (!SP2) S.a_ready(cur);
    if constexpr (SP2) {
        PG8_STAGE(PG8_SB(0, 0), cB, voffB); PG8_STAGE(PG8_SB(0, 1), cB + hstep, voffB);
        S.a_ready(cur);
        PG8_STAGE(PG8_SA(0, 0), cA, voffA); PG8_STAGE(PG8_SA(0, 1), cA + hstep, voffA);
        if (wr == 1) PG8_BAR;
        PG8_WAIT_V(2); PG8_BAR;
        PG8_STAGE(PG8_SB(1, 0), cB + kstep, voffB); PG8_STAGE(PG8_SA(1, 0), cA + kstep, voffA); PG8_STAGE(PG8_SB(1, 1), cB + hstep + kstep, voffB);
        PG8_WAIT_V(6); PG8_BAR;
    } else {
        PG8_STAGE(PG8_SB(0, 0), cB, voffB); PG8_STAGE(PG8_SA(0, 0), cA, voffA); PG8_STAGE(PG8_SB(0, 1), cB + hstep, voffB); PG8_STAGE(PG8_SA(0, 1), cA + hstep, voffA);
        if (wr == 1) PG8_BAR;
        PG8_WAIT_V(4); PG8_BAR;
        PG8_STAGE(PG8_SB(1, 0), cB + kstep, voffB); PG8_STAGE(PG8_SA(1, 0), cA + kstep, voffA); PG8_STAGE(PG8_SB(1, 1), cB + hstep + kstep, voffB);
        PG8_WAIT_V(6); PG8_BAR;
    }
    for (;;) {
        const bool has_next = S.next(ui + 1, nxt);
        const char* nA = has_next ? (const char*)g.A + (size_t)nxt.pm * tstep : cA; const char* nB = has_next ? (const char*)g.Bt + (size_t)nxt.pn * tstep : cB;
#pragma unroll 1
        for (int t = 0; t < nt; t += 2) {
            const bool last = (t == nt - 2);
            const char* a1 = cA + (size_t)(t + 1) * kstep;
            const char* a2 = last ? nA : cA + (size_t)(t + 2) * kstep; const char* b2 = last ? nB : cB + (size_t)(t + 2) * kstep;
            const char* a3 = a2 + kstep; const char* b3 = b2 + kstep;
            if (last && has_next) S.a_ready(nxt);
            if constexpr (SP2) {
            PG8_LDB(B0, 0, 0); PG8_LDB(B1, 0, 1); PG8_SCHED; PG8_LDA(At, 0, 0); PG8_STAGE(PG8_SA(1, 1), a1 + hstep, voffA);
            PG8_WAIT_V(8); PG8_WAIT_L(0); PG8_BAR; PG8_MMA(0, 0, At, B0); PG8_MMA(0, 1, At, B1); PG8_BAR; PG8_SCHED;
            PG8_LDA(At, 0, 1); PG8_STAGE(PG8_SB(0, 0), b2, voffB); PG8_STAGE(PG8_SB(0, 1), b2 + hstep, voffB); PG8_STAGE(PG8_SA(0, 0), a2, voffA);
            PG8_WAIT_V(8); PG8_WAIT_L(0); PG8_BAR; PG8_MMA(1, 0, At, B0); PG8_MMA(1, 1, At, B1); PG8_BAR; PG8_SCHED;
            PG8_LDB(B0, 1, 0); PG8_LDB(B1, 1, 1); PG8_SCHED; PG8_LDA(At, 1, 0); PG8_STAGE(PG8_SA(0, 1), a2 + hstep, voffA);
            PG8_WAIT_V(8); PG8_WAIT_L(0); PG8_BAR; PG8_MMA(0, 0, At, B0); PG8_MMA(0, 1, At, B1); PG8_BAR; PG8_SCHED;
            PG8_LDA(At, 1, 1); PG8_STAGE(PG8_SB(1, 0), b3, voffB); PG8_STAGE(PG8_SB(1, 1), b3 + hstep, voffB); PG8_STAGE(PG8_SA(1, 0), a3, voffA);
            PG8_WAIT_V(8); PG8_WAIT_L(0); PG8_BAR; PG8_MMA(1, 0, At, B0); PG8_MMA(1, 1, At, B1); PG8_BAR; PG8_SCHED;
            } else {
            PG8_LDB(B0, 0, 0); PG8_SCHED; PG8_LDA(At, 0, 0); PG8_STAGE(PG8_SA(1, 1), a1 + hstep, voffA);
            PG8_WAIT_L(8); PG8_BAR; PG8_WAIT_L(0); PG8_MMA(0, 0, At, B0); PG8_BAR; PG8_SCHED;
            PG8_LDB(B1, 0, 1); PG8_STAGE(PG8_SB(0, 0), b2, voffB);
            PG8_BAR; PG8_WAIT_L(0); PG8_MMA(0, 1, At, B1); PG8_BAR;
            PG8_LDA(At, 0, 1); PG8_STAGE(PG8_SA(0, 0), a2, voffA);
            PG8_BAR; PG8_WAIT_L(0); PG8_MMA(1, 0, At, B0); PG8_BAR; PG8_SCHED;
            PG8_STAGE(PG8_SB(0, 1), b2 + hstep, voffB);
            PG8_WAIT_V(6); PG8_BAR; PG8_MMA(1, 1, At, B1); PG8_BAR;
            PG8_LDB(B0, 1, 0); PG8_SCHED; PG8_LDA(At, 1, 0); PG8_STAGE(PG8_SA(0, 1), a2 + hstep, voffA);
            PG8_WAIT_L(8); PG8_BAR; PG8_WAIT_L(0); PG8_MMA(0, 0, At, B0); PG8_BAR; PG8_SCHED;
            PG8_LDB(B1, 1, 1); PG8_STAGE(PG8_SB(1, 0), b3, voffB);
            PG8_BAR; PG8_WAIT_L(0); PG8_MMA(0, 1, At, B1); PG8_BAR;
            PG8_LDA(At, 1, 1); PG8_STAGE(PG8_SA(1, 0), a3, voffA);
            PG8_BAR; PG8_WAIT_L(0); PG8_MMA(1, 0, At, B0); PG8_BAR; PG8_SCHED;
            PG8_STAGE(PG8_SB(1, 1), b3 + hstep, voffB);
            PG8_WAIT_V(6); PG8_BAR; PG8_MMA(1, 1, At, B1); PG8_BAR;
            }
        }
        if constexpr (ALIGN_EPI) { if (wr == 0) PG8_BAR; }
        if constexpr (!Epi::AFTER_DRAIN) { E(acc, cur, wr, wc, fr, fq); S.done(cur); }
        if (!has_next) break;
#pragma unroll
        for (int a = 0; a < 2; ++a)
#pragma unroll
            for (int b = 0; b < 2; ++b)
#pragma unroll
                for (int m = 0; m < 4; ++m)
#pragma unroll
                    for (int n = 0; n < 2; ++n) acc[a][b][m][n] = (f32x4){0.f, 0.f, 0.f, 0.f};
        cur = nxt; cA = nA; cB = nB; ++ui;
        if constexpr (ALIGN_EPI) { if (wr == 1) PG8_BAR; }
    }
    PG8_WAIT_V(0);
    if constexpr (!ALIGN_EPI) { if (wr == 0) PG8_BAR; }
    PG8_BAR;
    if constexpr (Epi::AFTER_DRAIN) { E.fused(acc, cur, wr, wc, fr, fq, lds, wid, lane); S.done(cur); }
#undef PG8_SA
#undef PG8_SB
#undef PG8_STAGE
#undef PG8_LDA
#undef PG8_LDB
#undef PG8_MMA
#undef PG8_WAIT_V
#undef PG8_WAIT_L
#undef PG8_BAR
#undef PG8_SCHED
}
}
namespace pg8 {
typedef unsigned u32x2 __attribute__((ext_vector_type(2)));
constexpr float RMS_EPS = 1e-6f;
__device__ __forceinline__ u32x4 pack8(f32x4 a, f32x4 b) { u32x4 w; w.x = cvt_pk_bf16(a[0], a[1]); w.y = cvt_pk_bf16(a[2], a[3]); w.z = cvt_pk_bf16(b[0], b[1]); w.w = cvt_pk_bf16(b[2], b[3]); return w; }
__device__ __forceinline__ float sumsq8(f32x4 a, f32x4 b) { return (a[0] * a[0] + a[1] * a[1]) + (a[2] * a[2] + a[3] * a[3]) + (b[0] * b[0] + b[1] * b[1]) + (b[2] * b[2] + b[3] * b[3]); }
__device__ __forceinline__ void rope8(f32x4& v0, f32x4& v1, const float* tab) {
    const f32x4 t0 = *(const f32x4*)tab, t1 = *(const f32x4*)(tab + 4);
    f32x4 a, b;
    a[0] = v0[0] * t0[0] - v0[1] * t0[1]; a[1] = v0[1] * t0[0] + v0[0] * t0[1];
    a[2] = v0[2] * t0[2] - v0[3] * t0[3]; a[3] = v0[3] * t0[2] + v0[2] * t0[3];
    b[0] = v1[0] * t1[0] - v1[1] * t1[1]; b[1] = v1[1] * t1[0] + v1[0] * t1[1];
    b[2] = v1[2] * t1[2] - v1[3] * t1[3]; b[3] = v1[3] * t1[2] + v1[2] * t1[3];
    v0 = a; v1 = b;
}
__device__ __forceinline__ void row_rstd(float (&rs)[2][4], const float* ss, int row0, float invn, float mul) {
    float t[2][4];
#pragma unroll
    for (int ai = 0; ai < 2; ++ai)
#pragma unroll
        for (int m = 0; m < 4; ++m) t[ai][m] = ss[row0 + ai * HALF + m * 16];
#pragma unroll
    for (int ai = 0; ai < 2; ++ai)
#pragma unroll
        for (int m = 0; m < 4; ++m) rs[ai][m] = rsqrtf(t[ai][m] * invn + RMS_EPS) * mul;
}
__device__ __forceinline__ void row_rstd4(float (&rs)[4], const float* ss, int row0, float invn, float mul) {
    float t[4];
#pragma unroll
    for (int m = 0; m < 4; ++m) t[m] = ss[row0 + m * 16];
#pragma unroll
    for (int m = 0; m < 4; ++m) rs[m] = rsqrtf(t[m] * invn + RMS_EPS) * mul;
}
struct EpiQKV {
    static constexpr bool PERM = true, AFTER_DRAIN = false;
    bf16_t* Q; size_t tstride; bf16_t* V; const float* ss; float qscale;
    unsigned* kmax2;
    __device__ __forceinline__ void operator()(const f32x4 (&acc)[2][2][4][2], const Unit& u, int wr, int wc, int fr, int fq) const {
        const int t = u.pn >> 2; bf16_t* base = t < 2 ? Q + (size_t)t * tstride : V; const float sc = t == 0 ? qscale : 1.f;
        const int col0 = (u.pn & 3) * 256 + wc * 32 + 8 * fq;
        float rsv[2][4]; row_rstd(rsv, ss, u.pm * BM + wr * 64 + fr, 1.f / 1024.f, 1.f);
#pragma unroll
        for (int ai = 0; ai < 2; ++ai)
#pragma unroll
            for (int m = 0; m < 4; ++m) { const int row = u.pm * BM + ai * HALF + wr * 64 + m * 16 + fr; const float rs = rsv[ai][m] * sc;
                bf16_t* rowp = base + (size_t)row * 1024 + col0;
#pragma unroll
                for (int bj = 0; bj < 2; ++bj) *(u32x4*)(rowp + bj * HALF) = pack8(acc[ai][bj][m][0] * rs, acc[ai][bj][m][1] * rs); }
        if (t == 1) {
#pragma unroll
            for (int bj = 0; bj < 2; ++bj) { float mx = 0.f;
#pragma unroll
                for (int ai = 0; ai < 2; ++ai)
#pragma unroll
                    for (int m = 0; m < 4; ++m) { const float rs = rsv[ai][m];
                        float s8 = sumsq8(acc[ai][bj][m][0] * rs, acc[ai][bj][m][1] * rs); s8 += __shfl_xor(s8, 16); s8 += __shfl_xor(s8, 32); mx = fmaxf(mx, s8); }
                mx = fmaxf(mx, __shfl_xor(mx, 1)); mx = fmaxf(mx, __shfl_xor(mx, 2)); mx = fmaxf(mx, __shfl_xor(mx, 4)); mx = fmaxf(mx, __shfl_xor(mx, 8));
                if (fr == 0 && fq == 0) atomicMax(kmax2 + ((u.pm >> 5) * 16 + (u.pn & 3) * 4 + bj * 2 + (wc >> 1)) * 2 + (wc & 1), __float_as_uint(mx)); }
        }
    }
};
__device__ __forceinline__ void unpack8(const u32x4 w, f32x4& a, f32x4& b) {
    a[0] = __uint_as_float(w.x << 16); a[1] = __uint_as_float(w.x & 0xffff0000u); a[2] = __uint_as_float(w.y << 16); a[3] = __uint_as_float(w.y & 0xffff0000u);
    b[0] = __uint_as_float(w.z << 16); b[1] = __uint_as_float(w.z & 0xffff0000u); b[2] = __uint_as_float(w.w << 16); b[3] = __uint_as_float(w.w & 0xffff0000u);
}
struct EpiRes {
    static constexpr bool PERM = true, AFTER_DRAIN = false;
    const float* basef; bf16_t* xb; bf16_t* lo; float* ss;
    __device__ __forceinline__ void operator()(const f32x4 (&acc)[2][2][4][2], const Unit& u, int wr, int wc, int fr, int fq) const {
        const int col0 = u.pn * BM + wc * 32 + 8 * fq; const size_t lo_pan = (size_t)u.pm * 262144;
#pragma unroll
        for (int ai = 0; ai < 2; ++ai) {
            f32x4 bv[4][2][2];
#pragma unroll
            for (int m = 0; m < 4; ++m) { const size_t off = (size_t)(u.pm * BM + ai * HALF + wr * 64 + m * 16 + fr) * 1024 + col0;
#pragma unroll
                for (int bj = 0; bj < 2; ++bj) {
                    if (basef) { bv[m][bj][0] = *(const f32x4*)(basef + off + bj * HALF); bv[m][bj][1] = *(const f32x4*)(basef + off + bj * HALF + 4); }
                    else { const u32x4 hw = *(const u32x4*)(xb + off + bj * HALF); f32x4 h0, h1; unpack8(hw, h0, h1);
                        if (lo) { const u32x4 lw = *(const u32x4*)(lo + lo_pan + off + bj * HALF); f32x4 l0, l1; unpack8(lw, l0, l1); h0 += l0; h1 += l1; }
                        bv[m][bj][0] = h0; bv[m][bj][1] = h1; } } }
            asm volatile("" ::: "memory");
#pragma unroll
            for (int m = 0; m < 4; ++m) { const int row = u.pm * BM + ai * HALF + wr * 64 + m * 16 + fr; const size_t off = (size_t)row * 1024 + col0; float s = 0.f;
#pragma unroll
                for (int bj = 0; bj < 2; ++bj) { const size_t o2 = off + bj * HALF; const f32x4 o0 = bv[m][bj][0] + acc[ai][bj][m][0], o1 = bv[m][bj][1] + acc[ai][bj][m][1];
                    s += sumsq8(o0, o1);
                    const u32x4 hw = pack8(o0, o1); f32x4 h0, h1; unpack8(hw, h0, h1);
                    *(u32x4*)(xb + o2) = hw; if (lo) *(u32x4*)(lo + lo_pan + o2) = pack8(o0 - h0, o1 - h1); }
                s += __shfl_xor(s, 16); s += __shfl_xor(s, 32);
                if (fq == 0) atomicAdd(ss + row, s); }
            asm volatile("" ::: "memory");
        }
    }
};
struct EpiResFinal {
    static constexpr bool PERM = true, AFTER_DRAIN = true;
    const bf16_t* xb; const bf16_t* lo; float* out; float* ss; const float* g; unsigned* cnt;
    __device__ __forceinline__ void fused(f32x4 (&acc)[2][2][4][2], const Unit& u, int wr, int wc, int fr, int fq, PG8_LAS unsigned char* lds, int wid, int lane) const {
        const int col0 = u.pn * BM + wc * 32 + 8 * fq; const size_t lo_pan = (size_t)u.pm * 262144;
#pragma unroll
        for (int ai = 0; ai < 2; ++ai) {
            u32x4 hv[4][2], lv[4][2];
#pragma unroll
            for (int m = 0; m < 4; ++m) { const size_t off = (size_t)(u.pm * BM + ai * HALF + wr * 64 + m * 16 + fr) * 1024 + col0;
#pragma unroll
                for (int bj = 0; bj < 2; ++bj) { hv[m][bj] = *(const u32x4*)(xb + off + bj * HALF); lv[m][bj] = lo ? *(const u32x4*)(lo + lo_pan + off + bj * HALF) : (u32x4){0u, 0u, 0u, 0u}; } }
            asm volatile("" ::: "memory");
#pragma unroll
            for (int m = 0; m < 4; ++m) { const int row = u.pm * BM + ai * HALF + wr * 64 + m * 16 + fr; float s = 0.f;
#pragma unroll
                for (int bj = 0; bj < 2; ++bj) { f32x4 h0, h1, l0, l1; unpack8(hv[m][bj], h0, h1); unpack8(lv[m][bj], l0, l1);
                    const f32x4 o0 = (h0 + l0) + acc[ai][bj][m][0], o1 = (h1 + l1) + acc[ai][bj][m][1]; acc[ai][bj][m][0] = o0; acc[ai][bj][m][1] = o1; s += sumsq8(o0, o1); }
                s += __shfl_xor(s, 16); s += __shfl_xor(s, 32);
                if (fq == 0) atomicAdd(ss + row, s); }
            asm volatile("" ::: "memory");
        }
        asm volatile("s_waitcnt vmcnt(0)" ::: "memory");
        __syncthreads();
        if (wid == 0 && lane == 0) {
            __builtin_amdgcn_fence(__ATOMIC_RELEASE, "agent");
            unsigned* c = cnt + 64 * u.pm;
            __hip_atomic_fetch_add(c, 1u, __ATOMIC_RELAXED, __HIP_MEMORY_SCOPE_AGENT);
            unsigned spins = 0u;
            while (__hip_atomic_load(c, __ATOMIC_RELAXED, __HIP_MEMORY_SCOPE_AGENT) < 4u) { __builtin_amdgcn_s_sleep(2); if (++spins > (1u << 22)) break; }
            __builtin_amdgcn_fence(__ATOMIC_ACQUIRE, "agent");
        }
        __syncthreads();
        f32x4 gv[2][2];
#pragma unroll
        for (int bj = 0; bj < 2; ++bj)
#pragma unroll
            for (int n = 0; n < 2; ++n) gv[bj][n] = *(const f32x4*)(g + col0 + bj * HALF + n * 4);
        float ssv[2][4];
#pragma unroll
        for (int ai = 0; ai < 2; ++ai)
#pragma unroll
            for (int m = 0; m < 4; ++m) ssv[ai][m] = __hip_atomic_load(ss + u.pm * BM + ai * HALF + wr * 64 + m * 16 + fr, __ATOMIC_RELAXED, __HIP_MEMORY_SCOPE_AGENT);
#pragma unroll
        for (int ai = 0; ai < 2; ++ai)
#pragma unroll
            for (int m = 0; m < 4; ++m) { const int row = u.pm * BM + ai * HALF + wr * 64 + m * 16 + fr; const size_t off = (size_t)row * 1024 + col0; const float rstd = rsqrtf(ssv[ai][m] * (1.f / 1024.f) + RMS_EPS);
#pragma unroll
                for (int bj = 0; bj < 2; ++bj)
#pragma unroll
                    for (int n = 0; n < 2; ++n) *(f32x4*)(out + off + bj * HALF + n * 4) = acc[ai][bj][m][n] * rstd * gv[bj][n]; }
    }
};
struct EpiUp {
    static constexpr bool PERM = true, AFTER_DRAIN = false;
    bf16_t* H; const float* ss;
    __device__ __forceinline__ void operator()(const f32x4 (&acc)[2][2][4][2], const Unit& u, int wr, int wc, int fr, int fq) const {
        const int col0 = u.pn * BM + wc * 32 + 8 * fq;
        float rsv[2][4]; row_rstd(rsv, ss, u.pm * BM + wr * 64 + fr, 1.f / 1024.f, 1.f);
#pragma unroll
        for (int ai = 0; ai < 2; ++ai)
#pragma unroll
            for (int m = 0; m < 4; ++m) { const int row = u.pm * BM + ai * HALF + wr * 64 + m * 16 + fr; const float rs = rsv[ai][m];
                bf16_t* rowp = H + (size_t)row * 4096 + col0;
#pragma unroll
                for (int bj = 0; bj < 2; ++bj) { f32x4 a = acc[ai][bj][m][0] * rs, b = acc[ai][bj][m][1] * rs;
#pragma unroll
                    for (int j = 0; j < 4; ++j) { a[j] = fmaxf(a[j], 0.f); a[j] *= a[j]; b[j] = fmaxf(b[j], 0.f); b[j] *= b[j]; }
                    *(u32x4*)(rowp + bj * HALF) = pack8(a, b); } }
    }
};
struct EpiQKVA {
    static constexpr bool PERM = true, AFTER_DRAIN = false;
    bf16_t* CKV; bf16_t* QA; bf16_t* KR; const float* ss; float* ss_kv; float* ss_q; const float* rope;
    __device__ __forceinline__ void operator()(const f32x4 (&acc)[2][2][4][2], const Unit& u, int wr, int wc, int fr, int fq) const {
        const int cb = wc * 32 + 8 * fq;
        float rsv[2][4]; row_rstd(rsv, ss, u.pm * BM + wr * 64 + fr, 1.f / 1024.f, 1.f);
#pragma unroll
        for (int ai = 0; ai < 2; ++ai)
#pragma unroll
            for (int m = 0; m < 4; ++m) { const int row = u.pm * BM + ai * HALF + wr * 64 + m * 16 + fr; const float rs = rsv[ai][m];
                float s = 0.f;
#pragma unroll
                for (int bj = 0; bj < 2; ++bj) { f32x4 a = acc[ai][bj][m][0] * rs, b = acc[ai][bj][m][1] * rs;
                    if (u.pn == 0) { *(u32x4*)(CKV + (size_t)row * 256 + bj * HALF + cb) = pack8(a, b); s += sumsq8(a, b); }
                    else if (u.pn == 1) { *(u32x4*)(QA + (size_t)row * 384 + bj * HALF + cb) = pack8(a, b); s += sumsq8(a, b); }
                    else if (bj == 0) { *(u32x4*)(QA + (size_t)row * 384 + 256 + cb) = pack8(a, b); s += sumsq8(a, b); }
                    else if (wc < 2) { rope8(a, b, rope + ((size_t)(row & 8191) * 32 + (cb >> 1)) * 2); *(u32x4*)(KR + (size_t)row * 64 + cb) = pack8(a, b); } }
                s += __shfl_xor(s, 16); s += __shfl_xor(s, 32);
                if (fq == 0) atomicAdd((u.pn == 0 ? ss_kv : ss_q) + row, s); }
    }
};
struct EpiKVB {
    static constexpr bool PERM = true, AFTER_DRAIN = false;
    bf16_t* KV; const float* ss_kv;
    __device__ __forceinline__ void operator()(const f32x4 (&acc)[2][2][4][2], const Unit& u, int wr, int wc, int fr, int fq) const {
        const int col0 = u.pn * BM + wc * 32 + 8 * fq;
#pragma unroll
        for (int ai = 0; ai < 2; ++ai) { float rs4[4]; row_rstd4(rs4, ss_kv, u.pm * BM + ai * HALF + wr * 64 + fr, 1.f / 256.f, 1.f);
#pragma unroll
            for (int m = 0; m < 4; ++m) { const int row = u.pm * BM + ai * HALF + wr * 64 + m * 16 + fr; const float rs = rs4[m];
                bf16_t* rowp = KV + (size_t)row * 2048 + col0;
#pragma unroll
                for (int bj = 0; bj < 2; ++bj) *(u32x4*)(rowp + bj * HALF) = pack8(acc[ai][bj][m][0] * rs, acc[ai][bj][m][1] * rs); }
            asm volatile("" ::: "memory"); }
    }
};
struct EpiQB {
    static constexpr bool PERM = true, AFTER_DRAIN = false;
    bf16_t* Q; const float* ss_q; float qscale;
    __device__ __forceinline__ void operator()(const f32x4 (&acc)[2][2][4][2], const Unit& u, int wr, int wc, int fr, int fq) const {
        const int col0 = u.pn * BM + wc * 32 + 8 * fq;
#pragma unroll
        for (int ai = 0; ai < 2; ++ai) { float rs4[4]; row_rstd4(rs4, ss_q, u.pm * BM + ai * HALF + wr * 64 + fr, 1.f / 384.f, qscale);
#pragma unroll
            for (int m = 0; m < 4; ++m) { const int row = u.pm * BM + ai * HALF + wr * 64 + m * 16 + fr; const float rs = rs4[m];
                bf16_t* rowp = Q + (size_t)row * 1536 + col0;
#pragma unroll
                for (int bj = 0; bj < 2; ++bj) { f32x4 a = acc[ai][bj][m][0] * rs, b = acc[ai][bj][m][1] * rs;
                    *(u32x4*)(rowp + bj * HALF) = pack8(a, b); } }
            asm volatile("" ::: "memory"); }
    }
};
}
namespace att {
typedef unsigned short bf16_t;
typedef short bf16x8 __attribute__((ext_vector_type(8)));
typedef short s16x4 __attribute__((ext_vector_type(4)));
typedef float f32x16 __attribute__((ext_vector_type(16)));
typedef float f32x4 __attribute__((ext_vector_type(4)));
typedef unsigned u32x4 __attribute__((ext_vector_type(4)));
#define ASBAR() __builtin_amdgcn_sched_barrier(0)
constexpr double LOG2E_D = 1.4426950408889634;
__device__ __forceinline__ int v_st(int k, int c) { const int kk = (k & ~0xC) | ((k & 4) << 1) | ((k & 8) >> 1); return ((kk >> 3) * 4 + (c >> 5)) * 512 + ((kk & 7) * 32 + (c & 31)) * 2; }
__device__ __forceinline__ int v_rd_base(int lane) { return ((lane & 3) << 3) | (((lane >> 2) & 3) << 6) | (((lane >> 4) & 1) << 5) | (((lane >> 5) & 1) << 8); }
__device__ __forceinline__ int crow(int r, int hi) { return (r & 3) + 8 * (r >> 2) + 4 * hi; }
__device__ __forceinline__ unsigned cvtpk(float lo, float hi) { unsigned r; asm volatile("v_cvt_pk_bf16_f32 %0, %1, %2" : "=v"(r) : "v"(lo), "v"(hi)); return r; }

struct Unit {
    const bf16_t* q[2]; int qs;
    const bf16_t* kA; int ksA;
    const bf16_t* kB; int ksB;
    const bf16_t* v; int vs;
    bf16_t* o; int os;
    const double* c;
    const unsigned* kmax2;
    const float* rtab;
    int q0, j_lo;
};
template <int DQK, int DV, bool BIAS> struct Lay {
    static constexpr int KROWB = DQK * 2, SHM_K = 64 * KROWB, SHM_V = 16384;
    static constexpr int OFF_K = 2 * SHM_V, OFF_WS = OFF_K + 2 * SHM_K, OFF_CK = OFF_WS + 2048, BYTES = OFF_CK + 32768;
};

template <int DQK, int DV, bool BIAS>
__device__ __forceinline__ void attn_unit(const Unit& U, char* lds) {
    typedef Lay<DQK, DV, BIAS> L;
    constexpr int NKB = DQK / 64, NVB = DV / 64, NQF = DQK / 16, NOD = DV / 32, KROWB = L::KROWB, SHM_K = L::SHM_K, SHM_V = L::SHM_V;
    int tid_ = threadIdx.x; asm volatile("" : "+v"(tid_));
    const int tid = tid_, wid = __builtin_amdgcn_readfirstlane(tid >> 6), lane = tid & 63, r32 = lane & 31, hi = lane >> 5;
    char* V_lds = lds; char* K_lds = lds + L::OFF_K;
    float* ws = (float*)(lds + L::OFF_WS) + wid * 64; float* li_l = ws; float* al_l = ws + 32;
    float* ckL = (float*)(lds + L::OFF_CK);
    const int q0 = U.q0;
    const int qlo = q0 + wid * 32, qrow = qlo + r32, qm = qrow - 4 * hi;
    const int vb0 = (int)(uintptr_t)V_lds + v_rd_base(lane);
    const unsigned lds0 = (unsigned)(uintptr_t)lds;
    const bf16_t* ksrc[NKB]; int kstep[NKB]; const bf16_t* vsrc[NVB];
#define A_SRCSETUP(KLO_) do { \
_Pragma("unroll") \
    for (int i = 0; i < NKB; ++i) { const int B_ = (wid * NKB + i) * 1024 + lane * 16, row = B_ / KROWB, ph = (B_ % KROWB) >> 4, lg = (ph & ~7) | ((ph & 7) ^ ((row >> 1) & 7)), col = lg * 8, blk = col >> 6; \
        const bool hiB = blk >= 2; const int st_ = hiB ? U.ksB : U.ksA; const size_t eo_ = (size_t)((KLO_) + row) * st_ + (hiB ? col - 128 : col); \
        ksrc[i] = (hiB ? U.kB : U.kA) + eo_; kstep[i] = 64 * st_; } \
_Pragma("unroll") \
    for (int i = 0; i < NVB; ++i) { const int B_ = (wid * NVB + i) * (DV == 64 ? 2048 : 1024) + lane * 16, st_ = B_ >> 9, e_ = (B_ & 511) >> 1, kk_ = (st_ >> 2) * 8 + (e_ >> 5); \
        const int k_ = (kk_ & ~0xC) | ((kk_ & 4) << 1) | ((kk_ & 8) >> 1), c_ = (st_ & 3) * 32 + (e_ & 31); \
        vsrc[i] = U.v + (size_t)((KLO_) + k_) * U.vs + c_; } \
    } while (0)
#define A_GLDS(gsrc, ldsdst) do { unsigned keep_; asm volatile("s_mov_b32 %0, m0\n\ts_mov_b32 m0, %2\n\ts_nop 0\n\tglobal_load_lds_dwordx4 %1, off\n\ts_mov_b32 m0, %0" : "=&s"(keep_) : "v"(gsrc), "s"(ldsdst) : "memory"); } while (0)
#define A_DMA(bf) do { \
        _Pragma("unroll") for (int i_ = 0; i_ < NKB; ++i_) { A_GLDS(ksrc[i_], (unsigned)__builtin_amdgcn_readfirstlane(lds0 + L::OFF_K + (bf) * SHM_K + (wid * NKB + i_) * 1024)); ksrc[i_] += kstep[i_]; } \
        _Pragma("unroll") for (int i_ = 0; i_ < NVB; ++i_) { A_GLDS(vsrc[i_], (unsigned)__builtin_amdgcn_readfirstlane(lds0 + (bf) * SHM_V + (wid * NVB + i_) * (DV == 64 ? 2048 : 1024))); vsrc[i_] += 64 * U.vs; } } while (0)
#define A_DMAWAIT() asm volatile("s_waitcnt vmcnt(0)" ::: "memory")
    double c0_ = 0.0, cqd_ = 0.0, csk_ = 0.0; unsigned k2a_ = 0u, k2b_ = 0u;
    if constexpr (BIAS) { c0_ = U.c[U.q0]; cqd_ = U.c[U.q0 + wid * 32 + r32]; if (tid < U.q0 / 64) csk_ = U.c[64 * tid + 63]; k2a_ = U.kmax2[0]; k2b_ = U.kmax2[1]; }
    else { A_SRCSETUP(U.j_lo * 64); A_DMA(0); }
    bf16x8 qr[NQF];
#pragma unroll
    for (int d0 = 0; d0 < NQF; ++d0) qr[d0] = *(const bf16x8*)(U.q[d0 >> 3] + (size_t)qrow * U.qs + (d0 & 7) * 16 + hi * 8);
    if constexpr (DQK == 192) {
#pragma unroll
        for (int d0 = 8; d0 < 12; ++d0) { const float* tab = U.rtab + ((size_t)qrow * 32 + 8 * (d0 - 8) + 4 * hi) * 2; const f32x4 t0 = *(const f32x4*)tab, t1 = *(const f32x4*)(tab + 4);
            const u32x4 w = *reinterpret_cast<const u32x4*>(&qr[d0]); u32x4 ov;
#pragma unroll
            for (int j = 0; j < 4; ++j) { const float a = __uint_as_float(w[j] << 16), b = __uint_as_float(w[j] & 0xffff0000u); const float c_ = j < 2 ? t0[2 * (j & 1)] : t1[2 * (j & 1)], s_ = j < 2 ? t0[2 * (j & 1) + 1] : t1[2 * (j & 1) + 1];
                ov[j] = cvtpk(a * c_ - b * s_, b * c_ + a * s_); }
            qr[d0] = *reinterpret_cast<const bf16x8*>(&ov); }
        char* qL_ = lds + L::OFF_CK + wid * 4096 + lane * 16;
#pragma unroll
        for (int d0 = 8; d0 < 12; ++d0) { *(bf16x8*)(qL_ + (d0 - 8) * 1024) = qr[d0]; }
        asm volatile("" ::: "memory"); }
    const char* qL = lds + L::OFF_CK + wid * 4096 + lane * 16;
    int j_lo = U.j_lo;
    if constexpr (BIAS) {
        float qn2 = 0.f;
#pragma unroll
        for (int d0 = 0; d0 < NQF; ++d0) { const u32x4 w = *reinterpret_cast<const u32x4*>(&qr[d0]);
#pragma unroll
            for (int j = 0; j < 4; ++j) { const float a = __uint_as_float(w[j] << 16), b = __uint_as_float(w[j] & 0xffff0000u); qn2 += a * a + b * b; } }
        { auto rr = __builtin_amdgcn_permlane32_swap(__float_as_uint(qn2), __float_as_uint(qn2), false, false); qn2 = __uint_as_float(rr[0]) + __uint_as_float(rr[1]); }
#pragma unroll
        for (int o_ = 1; o_ < 32; o_ <<= 1) qn2 = fmaxf(qn2, __shfl_xor(qn2, o_));
        float* wsb = (float*)(lds + L::OFF_WS);
        if (lane == 0) wsb[wid * 64] = qn2;
        __syncthreads();
        float qmax2 = wsb[0];
#pragma unroll
        for (int w = 1; w < 8; ++w) qmax2 = fmaxf(qmax2, wsb[w * 64]);
        const float k2 = __uint_as_float(k2a_) + __uint_as_float(k2b_);
        const float thr = 2.f * (sqrtf(qmax2 * k2) * 1.02f + 1e-3f) + 160.f;
        const int nprev = q0 / 64;
        bool sk = false; if (tid < nprev) sk = (float)((csk_ - c0_) * LOG2E_D) > thr;
        const unsigned long long bal = __ballot(sk);
        if (lane == 0) ((int*)wsb)[wid * 64 + 1] = __popcll(bal);
        __syncthreads();
        int cnt = 0;
#pragma unroll
        for (int w = 0; w < 8; ++w) cnt += ((int*)wsb)[w * 64 + 1];
        j_lo = cnt;
    }
    const int klo = j_lo * 64, NT = (q0 + 256) / 64 - j_lo;
    float cq = 0.f;
    if constexpr (BIAS) { A_SRCSETUP(klo); A_DMA(0);
        const double cref = c0_; cq = (float)((cqd_ - cref) * LOG2E_D);
        for (int s = klo + tid; s < q0 + 256; s += 512) ckL[s - klo] = (float)((U.c[s] - cref) * LOG2E_D); }
    A_DMAWAIT();
    __syncthreads();
    float mhat = 0.f, l_reg = 0.f; f32x16 o[NOD]; f32x16 negm; _Pragma("unroll") for (int r = 0; r < 16; ++r) negm[r] = cq; asm volatile("" : "+v"(negm));
#pragma unroll
    for (int d = 0; d < NOD; ++d) o[d] = f32x16{};
    const char* kbase = K_lds + r32 * KROWB;
    const int ksw = ((r32 >> 1) & 7) << 4;
#define A_TRRD(dst, off) asm volatile("ds_read_b64_tr_b16 %0, %1 offset:%2" : "=&v"(dst) : "v"(vb0), "i"(off) : "memory")
#define A_PV_RD(X, d0, BUF) do { constexpr int b_ = (BUF) * SHM_V + (d0) * 512; \
        A_TRRD(X##l0, b_); A_TRRD(X##h0, b_ + 2048); A_TRRD(X##l1, b_ + 4096); A_TRRD(X##h1, b_ + 6144); A_TRRD(X##l2, b_ + 8192); A_TRRD(X##h2, b_ + 10240); A_TRRD(X##l3, b_ + 12288); A_TRRD(X##h3, b_ + 14336); } while (0)
#define A_PV_MM(X, d0) do { \
        o[d0] = __builtin_amdgcn_mfma_f32_32x32x16_bf16(pa0, (bf16x8){X##l0[0], X##l0[1], X##l0[2], X##l0[3], X##h0[0], X##h0[1], X##h0[2], X##h0[3]}, o[d0], 0, 0, 0); \
        o[d0] = __builtin_amdgcn_mfma_f32_32x32x16_bf16(pa1, (bf16x8){X##l1[0], X##l1[1], X##l1[2], X##l1[3], X##h1[0], X##h1[1], X##h1[2], X##h1[3]}, o[d0], 0, 0, 0); \
        o[d0] = __builtin_amdgcn_mfma_f32_32x32x16_bf16(pa2, (bf16x8){X##l2[0], X##l2[1], X##l2[2], X##l2[3], X##h2[0], X##h2[1], X##h2[2], X##h2[3]}, o[d0], 0, 0, 0); \
        o[d0] = __builtin_amdgcn_mfma_f32_32x32x16_bf16(pa3, (bf16x8){X##l3[0], X##l3[1], X##l3[2], X##l3[3], X##h3[0], X##h3[1], X##h3[2], X##h3[3]}, o[d0], 0, 0, 0); } while (0)
#define A_LGKM(n) do { asm volatile("s_waitcnt lgkmcnt(" #n ")" ::: "memory"); ASBAR(); } while (0)
#define A_PV_ALL(BUF) do { s16x4 al0, al1, al2, al3, ah0, ah1, ah2, ah3, bl0, bl1, bl2, bl3, bh0, bh1, bh2, bh3; \
        A_PV_RD(a, 0, BUF); A_PV_RD(b, 1, BUF); A_LGKM(8); A_PV_MM(a, 0); ASBAR(); \
        if constexpr (NOD > 2) { A_PV_RD(a, 2 % NOD, BUF); A_LGKM(8); A_PV_MM(b, 1); ASBAR(); A_PV_RD(b, 3 % NOD, BUF); A_LGKM(8); A_PV_MM(a, 2 % NOD); ASBAR(); A_LGKM(0); A_PV_MM(b, 3 % NOD); } \
        else { A_LGKM(0); A_PV_MM(b, 1); } } while (0)
#define A_PK4(P, B_, OUT) do { unsigned a0 = cvtpk(P[B_ + 0], P[B_ + 1]), a1 = cvtpk(P[B_ + 2], P[B_ + 3]); unsigned b0 = cvtpk(P[B_ + 4], P[B_ + 5]), b1 = cvtpk(P[B_ + 6], P[B_ + 7]); \
        auto r0 = __builtin_amdgcn_permlane32_swap(a0, b0, false, false); auto r1 = __builtin_amdgcn_permlane32_swap(a1, b1, false, false); \
        u32x4 w = {r0[0], r1[0], r0[1], r1[1]}; OUT = *reinterpret_cast<bf16x8*>(&w); } while (0)
#define A_TILE(BUF, t, FIRST) do { \
        const int kb_ = klo + (t) * 64; const bool more_ = (t) + 1 < NT; \
        if (more_) A_DMA(1 - (BUF)); \
        ASBAR(); \
        f32x16 p0, p1; \
        _Pragma("unroll") for (int d0 = 0; d0 < NQF; ++d0) { const char* a_ = kbase + (BUF) * SHM_K + (d0 >> 2) * 128 + ((((d0 & 3) * 32) + hi * 16) ^ ksw); \
            const bf16x8 b0 = *(const bf16x8*)a_; const bf16x8 b1 = *(const bf16x8*)(a_ + 32 * KROWB); \
            const bf16x8 qf_ = d0 < 8 ? qr[d0 < 8 ? d0 : 0] : *(const bf16x8*)(qL + (d0 - 8) * 1024); \
            if (d0 == 0) { p0 = __builtin_amdgcn_mfma_f32_32x32x16_bf16(b0, qf_, negm, 0, 0, 0); p1 = __builtin_amdgcn_mfma_f32_32x32x16_bf16(b1, qf_, negm, 0, 0, 0); } \
            else { p0 = __builtin_amdgcn_mfma_f32_32x32x16_bf16(b0, qf_, p0, 0, 0, 0); p1 = __builtin_amdgcn_mfma_f32_32x32x16_bf16(b1, qf_, p1, 0, 0, 0); } if ((d0 & 1) == 1) ASBAR(); } \
        ASBAR(); \
        if constexpr (BIAS) { const float* ck_ = ckL + (kb_ - klo) + 4 * hi; \
            f32x16 cv0, cv1; \
            _Pragma("unroll") for (int g = 0; g < 4; ++g) { const f32x4 c0 = *(const f32x4*)(ck_ + 8 * g), c1 = *(const f32x4*)(ck_ + 32 + 8 * g); \
                _Pragma("unroll") for (int j = 0; j < 4; ++j) { cv0[4 * g + j] = c0[j]; cv1[4 * g + j] = c1[j]; } } \
            p0 = p0 - cv0; p1 = p1 - cv1; }     \
        if (kb_ + 63 > qlo) { const float NEG = -__builtin_inff(); const int dq = qm - kb_; \
            _Pragma("unroll") for (int r = 0; r < 16; ++r) { const int c = (r & 3) + 8 * (r >> 2); if (dq - c < 0) p0[r] = NEG; if (dq - c - 32 < 0) p1[r] = NEG; } } \
        float pmax = __builtin_fmaxf(__builtin_fmaxf(p0[0], p0[1]), p1[0]); float pmb = __builtin_fmaxf(__builtin_fmaxf(p0[2], p0[3]), p1[1]); pmax = __builtin_fmaxf(__builtin_fmaxf(pmax, p1[2]), p1[3]); \
        _Pragma("unroll") for (int r = 4; r < 16; r += 4) { pmax = __builtin_fmaxf(__builtin_fmaxf(pmax, p0[r]), p0[r + 1]); pmb = __builtin_fmaxf(__builtin_fmaxf(pmb, p0[r + 2]), p0[r + 3]); \
            pmax = __builtin_fmaxf(__builtin_fmaxf(pmax, p1[r]), p1[r + 1]); pmb = __builtin_fmaxf(__builtin_fmaxf(pmb, p1[r + 2]), p1[r + 3]); } \
        pmax = __builtin_fmaxf(pmax, pmb); \
        { auto rr = __builtin_amdgcn_permlane32_swap(__float_as_uint(pmax), __float_as_uint(pmax), false, false); pmax = fmaxf(__uint_as_float(rr[0]), __uint_as_float(rr[1])); } \
        if ((FIRST) || __any(pmax > 8.f)) { const float dl = (FIRST) ? pmax : fmaxf(pmax, 0.f); mhat += dl; \
            _Pragma("unroll") for (int r = 0; r < 16; ++r) { p0[r] -= dl; p1[r] -= dl; } \
            _Pragma("unroll") for (int r = 0; r < 16; ++r) negm[r] = cq - mhat; asm volatile("" : "+v"(negm)); \
            if (!(FIRST)) { const float alpha = __builtin_amdgcn_exp2f(-dl); l_reg *= alpha; if (hi == 0) al_l[r32] = alpha; asm volatile("s_waitcnt lgkmcnt(0)" ::: "memory"); \
                _Pragma("unroll") for (int d_ = 0; d_ < NOD; ++d_) _Pragma("unroll") for (int r = 0; r < 16; ++r) o[d_][r] *= al_l[crow(r, hi)]; } } \
        _Pragma("unroll") for (int r = 0; r < 16; ++r) { p0[r] = __builtin_amdgcn_exp2f(p0[r]); p1[r] = __builtin_amdgcn_exp2f(p1[r]); } \
        { const f32x16 sv = p0 + p1; float ps = ((sv[0] + sv[1]) + (sv[2] + sv[3])) + ((sv[4] + sv[5]) + (sv[6] + sv[7])) + (((sv[8] + sv[9]) + (sv[10] + sv[11])) + ((sv[12] + sv[13]) + (sv[14] + sv[15]))); \
          auto rr = __builtin_amdgcn_permlane32_swap(__float_as_uint(ps), __float_as_uint(ps), false, false); l_reg += __uint_as_float(rr[0]) + __uint_as_float(rr[1]); } \
        bf16x8 pa0, pa1, pa2, pa3; A_PK4(p0, 0, pa0); A_PK4(p0, 8, pa1); A_PK4(p1, 0, pa2); A_PK4(p1, 8, pa3); \
        ASBAR(); \
        A_PV_ALL(BUF); \
        A_DMAWAIT(); \
        __syncthreads(); } while (0)
    A_TILE(0, 0, true);
    int t = 1;
    for (; t + 1 < NT; t += 2) { A_TILE(1, t, false); A_TILE(0, t + 1, false); }
    if (t < NT) { A_TILE(1, t, false); }
    if (hi == 0) li_l[r32] = l_reg; asm volatile("s_waitcnt lgkmcnt(0)" ::: "memory");
    bf16_t* Ow = U.o + (size_t)qlo * U.os;
#pragma unroll
    for (int r = 0; r < 16; ++r) { const int orow = crow(r, hi); const float rl = __builtin_amdgcn_rcpf(li_l[orow]);
#pragma unroll
        for (int d0 = 0; d0 < NOD; ++d0) { const float v = o[d0][r] * rl; const float vn = __shfl_xor(v, 1);
            if ((r32 & 1) == 0) *(unsigned*)(Ow + (size_t)orow * U.os + d0 * 32 + r32) = cvtpk(v, vn); } }
    __syncthreads();
#undef A_GLDS
#undef A_SRCSETUP
#undef A_DMA
#undef A_DMAWAIT
#undef A_TRRD
#undef A_PV_RD
#undef A_PV_MM
#undef A_PV_ALL
#undef A_LGKM
#undef A_PK4
#undef A_TILE
}
}
#define LAS __attribute__((address_space(3)))
#define XB_TMO      128
#define XB_XCNT(j)  (256  + 64 * (j))
#define XB_XSUB(j)  (1280 + 64 * (j))
#define XB_XGEN(j)  (2304 + 64 * (j))
#define XB_TOP      3328
#define XB_TOPGEN   3392
#define XCD_BAR_WORDS 3456
#define XB_SPIN_CAP (1u << 18)

__device__ __forceinline__ unsigned xb_ld(unsigned* p)              { return __hip_atomic_load(p, __ATOMIC_RELAXED, __HIP_MEMORY_SCOPE_AGENT); }
__device__ __forceinline__ unsigned xb_add(unsigned* p, unsigned v) { return __hip_atomic_fetch_add(p, v, __ATOMIC_RELAXED, __HIP_MEMORY_SCOPE_AGENT); }
__device__ __forceinline__ unsigned xb_xcc_id() { return (unsigned)__builtin_amdgcn_s_getreg((3 << 11) | 20) & 0xFu; }
#define XB_SPIN(cond, bar) do { unsigned _sp = 0; while (cond) { __builtin_amdgcn_s_sleep(1); \
    if ((++_sp & 255u) == 0u) { if (xb_ld(&(bar)[XB_TMO])) break; if (_sp > XB_SPIN_CAP) { atomicAdd(&(bar)[XB_TMO], 1u); break; } } } } while (0)

struct XcdBarrier {
    unsigned* bar; unsigned x;
    volatile LAS unsigned* st;
};

__device__ __forceinline__ XcdBarrier xcd_barrier_post(unsigned* bar, volatile LAS unsigned* st) {
    XcdBarrier b; b.bar = bar; b.x = xb_xcc_id(); b.st = st;
    if (threadIdx.x == 0) (void)xb_add(&bar[XB_XCNT(b.x)], 1u);
    return b;
}
__device__ __forceinline__ void xcd_barrier_complete(unsigned* bar, unsigned x, unsigned& nloc, unsigned& nx) {
    const unsigned G = gridDim.x * gridDim.y * gridDim.z;
    unsigned sum, cnt, mine, sp = 0u;
    for (;;) {
        sum = 0u; cnt = 0u; mine = 0u;
#pragma unroll
        for (unsigned j = 0; j < 16; ++j) { const unsigned c = xb_ld(&bar[XB_XCNT(j)]); sum += c; cnt += (c > 0u) ? 1u : 0u; mine = (j == x) ? c : mine; }
        if (sum == G) break;
        __builtin_amdgcn_s_sleep(1);
        if ((++sp & 255u) == 0u) { if (xb_ld(&bar[XB_TMO])) break; if (sp > XB_SPIN_CAP) { atomicAdd(&bar[XB_TMO], 1u); break; } }
    }
    nloc = mine > 0u ? mine : 1u; nx = cnt > 0u ? cnt : 1u;
}

__device__ __forceinline__ void xcd_barrier(const XcdBarrier& b) {
    asm volatile("s_waitcnt vmcnt(0)" ::: "memory");
    __syncthreads();
    if (threadIdx.x == 0) {
        unsigned* bar = b.bar;
        __builtin_amdgcn_s_waitcnt(0);
        unsigned nloc = b.st[0], nx = b.st[1];
        if (nloc == 0u) { xcd_barrier_complete(bar, b.x, nloc, nx); b.st[0] = nloc; b.st[1] = nx; }
        const unsigned old = xb_add(&bar[XB_XSUB(b.x)], 1u);
        const unsigned gen = old / nloc;
        if (old + 1u == (gen + 1u) * nloc) {
            __builtin_amdgcn_fence(__ATOMIC_RELEASE, "agent");
            asm volatile("s_waitcnt vmcnt(0)" ::: "memory");
            const unsigned og = xb_add(&bar[XB_TOP], 1u);
            const unsigned tg = og / nx;
            if (og + 1u == (tg + 1u) * nx) xb_add(&bar[XB_TOPGEN], 1u);
            else XB_SPIN(xb_ld(&bar[XB_TOPGEN]) == tg, bar);
            __builtin_amdgcn_fence(__ATOMIC_ACQUIRE, "agent");
            xb_add(&bar[XB_XGEN(b.x)], 1u);
            asm volatile("s_waitcnt vmcnt(0)" ::: "memory");
        } else {
            XB_SPIN(xb_ld(&bar[XB_XGEN(b.x)]) == gen, bar);
            __builtin_amdgcn_fence(__ATOMIC_ACQUIRE, "agent");
            asm volatile("s_waitcnt vmcnt(0)" ::: "memory");
        }
    }
    __syncthreads();
}
typedef unsigned short bf16;
typedef unsigned v4u __attribute__((ext_vector_type(4)));
typedef float f32x4 __attribute__((ext_vector_type(4)));
constexpr int NWAVES = 8, M = 16384, SEQ = 8192, D = 1024, FF = 4096;
constexpr float RMS_EPS = 1e-6f;
constexpr float C2_FOX = 0.125f * 1.4426950408889634f;
constexpr float C2_MLA = 0.07216878364870323f * 1.4426950408889634f;
constexpr size_t MiB = 1u << 20;
constexpr size_t WS_CTL = 0, CTL_ZERO_BYTES = 1 * MiB;
constexpr size_t WS_ROPE = 1 * MiB, WS_LF = 3 * MiB, WS_C = 4 * MiB;
constexpr size_t WS_W = 8 * MiB;
constexpr size_t W_FIN = WS_W, W_FOUT = W_FIN + 6 * MiB, W_QKVA = W_FOUT + 2 * MiB, W_KVB = W_QKVA + 2 * MiB, W_QB = W_KVB + 1 * MiB, W_MOUT = W_QB + 2 * MiB,
                 W_UP0 = W_MOUT + 2 * MiB, W_UP1 = W_UP0 + 8 * MiB, W_DN0 = W_UP1 + 8 * MiB, W_DN1 = W_DN0 + 8 * MiB, W_END = W_DN1 + 8 * MiB;
constexpr size_t WS_XB = 56 * MiB;
constexpr size_t WS_H = 88 * MiB;
constexpr size_t WS_MKV = 88 * MiB, WS_MQ = 152 * MiB, WS_MKR = 248 * MiB  , WS_MO = 216 * MiB  , WS_CKV = 234 * MiB, WS_QA = 242 * MiB, WS_END = 254 * MiB;
static_assert(W_END <= WS_XB, "weights");
constexpr int SS_WORDS = 16384;
enum { SS0 = 1, SS1 = 2, SS2 = 3, SSKV = 4, SSQ = 5, SS3 = 6, SS4 = 7 };
constexpr int LDS_BYTES = 147456;

#define LDS_WAIT() asm volatile("s_waitcnt lgkmcnt(0)" ::: "memory")
__device__ __forceinline__ unsigned f2bf(float f) { unsigned u = __builtin_bit_cast(unsigned, f); return (u + 0x7fffu + ((u >> 16) & 1u)) >> 16; }
__device__ __forceinline__ unsigned pk2(float lo, float hi) { return f2bf(lo) | (f2bf(hi) << 16); }
__device__ __forceinline__ float wave_sum(float v) {
#pragma unroll
    for (int o = 1; o < 64; o <<= 1) v += __shfl_xor(v, o);
    return v;
}
__device__ __forceinline__ double wave_sum_d(double v) {
#pragma unroll
    for (int o = 1; o < 64; o <<= 1) { const int thi = __shfl_xor(__double2hiint(v), o), tlo = __shfl_xor(__double2loint(v), o); v += __hiloint2double(thi, tlo); }
    return v;
}
__device__ __forceinline__ void tr_item2(const float* W, int ldw, int srccol  , const float* g, int K, int k0, int n0, bf16* WT, LAS float* scr, int lane) {
    float t[32];
    const float* colp = W + (size_t)(k0 + (lane >> 5)) * ldw + (srccol < 0 ? 0 : srccol);
#pragma unroll
    for (int i = 0; i < 32; ++i) t[i] = colp[(size_t)(2 * i) * ldw];
    const float zf = srccol < 0 ? 0.f : 1.f;
#pragma unroll
    for (int i = 0; i < 32; ++i) scr[(2 * i + (lane >> 5)) * 33 + (lane & 31)] = t[i] * zf;
    const int c = lane & 7;
    f32x4 ga = {1.f, 1.f, 1.f, 1.f}, gb = {1.f, 1.f, 1.f, 1.f};
    if (g) { ga = *(const f32x4*)(g + k0 + 8 * c); gb = *(const f32x4*)(g + k0 + 8 * c + 4); }
    LDS_WAIT(); asm volatile("" ::: "memory");
#pragma unroll
    for (int j = 0; j < 4; ++j) { const int n = (lane >> 3) + 8 * j; const LAS float* sp = scr + (8 * c) * 33 + n;
        v4u o; o.x = pk2(sp[0 * 33] * ga.x, sp[1 * 33] * ga.y); o.y = pk2(sp[2 * 33] * ga.z, sp[3 * 33] * ga.w); o.z = pk2(sp[4 * 33] * gb.x, sp[5 * 33] * gb.y); o.w = pk2(sp[6 * 33] * gb.z, sp[7 * 33] * gb.w);
        *(v4u*)(WT + (size_t)(n0 + n) * K + k0 + 8 * c) = o; }
    LDS_WAIT(); asm volatile("" ::: "memory");
}

namespace pg8 {
struct FlexOrder : StaticOrder {
    int panel, ppm, member;
    const unsigned* wait_word;
    __device__ __forceinline__ bool next(int i, Unit& u) const {
        if (panel) { const int pn = member + 4 * i; if (pn >= nN) return false; u.pm = ppm; u.pn = pn; return true; }
        return StaticOrder::next(i, u);
    }
    __device__ __forceinline__ void a_ready(const Unit& u) const {
        if (wait_word && u.pn == member) {
            if (threadIdx.x == 0) { unsigned sp = 0u;
                while (__hip_atomic_load(wait_word, __ATOMIC_RELAXED, __HIP_MEMORY_SCOPE_AGENT) < 4u) { __builtin_amdgcn_s_sleep(1); if (++sp > (1u << 22)) break; }
                __builtin_amdgcn_fence(__ATOMIC_ACQUIRE, "agent");
                asm volatile("s_waitcnt vmcnt(0)" ::: "memory"); }
            asm volatile("" ::: "memory"); __builtin_amdgcn_s_barrier(); asm volatile("" ::: "memory");
        }
    }
};
}
__device__ __forceinline__ void group_barrier(unsigned* cnt, bool same_l2) {
    asm volatile("s_waitcnt vmcnt(0)" ::: "memory");
    __syncthreads();
    if (threadIdx.x == 0) {
        if (!same_l2) __builtin_amdgcn_fence(__ATOMIC_RELEASE, "agent");
        asm volatile("s_waitcnt vmcnt(0)" ::: "memory");
        __hip_atomic_fetch_add(cnt, 1u, __ATOMIC_RELAXED, __HIP_MEMORY_SCOPE_AGENT);
        unsigned sp = 0u;
        while (__hip_atomic_load(cnt, __ATOMIC_RELAXED, __HIP_MEMORY_SCOPE_AGENT) < 4u) { __builtin_amdgcn_s_sleep(1); if (++sp > (1u << 22)) break; }
        __builtin_amdgcn_fence(__ATOMIC_ACQUIRE, "agent");
        asm volatile("s_waitcnt vmcnt(0)" ::: "memory");
    }
    __syncthreads();
}
__device__ __forceinline__ void group_arrive(unsigned* cnt, bool same_l2) {
    asm volatile("s_waitcnt vmcnt(0)" ::: "memory");
    __syncthreads();
    if (threadIdx.x == 0) {
        if (!same_l2) __builtin_amdgcn_fence(__ATOMIC_RELEASE, "agent");
        asm volatile("s_waitcnt vmcnt(0)" ::: "memory");
        __hip_atomic_fetch_add(cnt, 1u, __ATOMIC_RELAXED, __HIP_MEMORY_SCOPE_AGENT);
    }
}
#ifndef PROBE_PH
#define PROBE_PH -1
#endif
struct Args { const float* in[17]; float* out; unsigned char* ws; int ph_lo, ph_hi; };

__global__ void __launch_bounds__(NWAVES * 64, 2) yoco_fwd(Args args) {
    extern __shared__ __attribute__((aligned(16))) unsigned char lds[];
    cg::grid_group grid = cg::this_grid();
#define TID_INIT() int tid_ = threadIdx.x; asm volatile("" : "+v"(tid_)); const int tid = tid_, lane = tid & 63, wave = __builtin_amdgcn_readfirstlane(tid >> 6); const int gw = vcu * NWAVES + wave; (void)lane; (void)gw
    const int G = gridDim.x, bx = blockIdx.x;
    for (int u_ = threadIdx.x; u_ < (LDS_BYTES - 131072) / 4; u_ += NWAVES * 64) ((LAS unsigned*)(lds + 131072))[u_] = 0u;
    __syncthreads();
    const XcdBarrier xbar = xcd_barrier_post((unsigned*)(args.ws + WS_CTL) + 4096, (volatile LAS unsigned*)(lds + 131072 + 320) + 8);
    const bool panel_mode = (G == 256);
    const int g_pm = 8 * (bx & 7) + ((bx >> 3) & 7), g_mem = bx >> 6;
    unsigned* const gctl = (unsigned*)(args.ws + WS_CTL + 576 * 1024);
    if (panel_mode && threadIdx.x == 0) __hip_atomic_store(gctl + bx, xb_xcc_id() + 1u, __ATOMIC_RELAXED, __HIP_MEMORY_SCOPE_AGENT);
    bool same_l2 = false;
    const int vcu = (G % 8 == 0) ? (bx % 8) * (G / 8) + bx / 8 : bx;
#define ws (args.ws)
#define x_in (args.in[0])
#define g_mix (args.in[1])
#define g_ffn (args.in[2])
#define w_fin (args.in[3])
#define b_f (args.in[4])
#define w_fout (args.in[5])
#define g_kv (args.in[6])
#define w_kva (args.in[7])
#define g_kva (args.in[8])
#define w_kvb (args.in[9])
#define w_qa (args.in[10])
#define g_qa (args.in[11])
#define w_qb (args.in[12])
#define w_mout (args.in[13])
#define w_up (args.in[14])
#define w_dn (args.in[15])
#define g_fin (args.in[16])
#define out (args.out)
#define ssb ((float*)(ws + WS_CTL))
#define SS(i) (ssb + (size_t)(i) * SS_WORDS)
#define rope ((float*)(ws + WS_ROPE))
#define lf ((float*)(ws + WS_LF))
#define cc ((double*)(ws + WS_C))
#define XB ((bf16*)(ws + WS_XB))
#define FQB ((bf16*)out)
#define FKB ((bf16*)out + (size_t)M * 1024)
#define FVB ((bf16*)(ws + WS_MO))
#define CKVB ((bf16*)out)
#define QAB ((bf16*)out + (size_t)M * 256)
#ifndef STREAM_LO
#define STREAM_LO 0
#endif
#define LOB (STREAM_LO ? (bf16*)out : (bf16*)nullptr)
#define HB ((bf16*)(ws + WS_H))
    const int lo = args.ph_lo, hi_ph = args.ph_hi;
#ifndef PHMASK
#define PHMASK 0xffffffffu
#endif
#define IN(k) (((PHMASK >> (k)) & 1u) && lo <= (k) && (k) < hi_ph)
#define SEAM(k) do { if (IN(k) && IN((k) + 1)) { if (args.ph_lo < 0) grid.sync();   xcd_barrier(xbar); } } while (0)
    const int NGW = G * NWAVES;
#define GSEAM(k) do { if (IN(k) && IN((k) + 1)) { if (panel_mode) group_barrier(gctl + 1024 + ((k) * 64 + g_pm) * 16, same_l2); else xcd_barrier(xbar); } } while (0)
#define FLEX(S, N_) pg8::FlexOrder S; S.init(M, (N_), G, bx); S.panel = panel_mode ? 1 : 0; S.ppm = g_pm; S.member = g_mem; S.wait_word = nullptr
#define GARRIVE(k) do { if (IN(k) && IN((k) + 1)) { if (panel_mode) group_arrive(gctl + 1024 + ((k) * 64 + g_pm) * 16, same_l2); else xcd_barrier(xbar); } } while (0)
#define FLEXW(S, N_, k) FLEX(S, N_); S.wait_word = (panel_mode && IN(k) && IN((k) + 1)) ? gctl + 1024 + ((k) * 64 + g_pm) * 16 : nullptr

    if (IN(0)) for (int rep_ = 0; rep_ < (PROBE_PH == 0 ? 2 : 1); ++rep_) { TID_INIT();
        LAS float* gwl = (LAS float*)lds;
        for (int i = tid; i < 4 * 1024; i += NWAVES * 64) { const int k = i >> 2, h4 = (i & 3) * 4; const f32x4 w4 = *(const f32x4*)(w_fin + (size_t)k * 3088 + 3072 + h4); const float gk = g_mix[k];
            gwl[(h4 + 0) * 1024 + k] = w4.x * gk; gwl[(h4 + 1) * 1024 + k] = w4.y * gk; gwl[(h4 + 2) * 1024 + k] = w4.z * gk; gwl[(h4 + 3) * 1024 + k] = w4.w * gk; }
        __syncthreads();
        {
            f32x4 v[4], vn[4];
            const int NRW = NGW;
            int m = gw;
            if (m < M) { const f32x4* xr = (const f32x4*)(x_in + (size_t)m * D) + lane;
#pragma unroll
                for (int j = 0; j < 4; ++j) v[j] = xr[64 * j]; }
            for (; m < M; m += NRW) {
                const int mn = m + NRW;
                if (mn < M) { const f32x4* xr = (const f32x4*)(x_in + (size_t)mn * D) + lane;
#pragma unroll
                    for (int j = 0; j < 4; ++j) vn[j] = xr[64 * j]; }
                float s = 0.f;
#pragma unroll
                for (int j = 0; j < 4; ++j) s += (v[j].x * v[j].x + v[j].y * v[j].y) + (v[j].z * v[j].z + v[j].w * v[j].w);
                s = wave_sum(s);
                if (lane == 0) SS(SS0)[m] = s;
                unsigned long long* o8 = (unsigned long long*)(XB + (size_t)m * D) + lane;
#pragma unroll
                for (int j = 0; j < 4; ++j) o8[64 * j] = (unsigned long long)pk2(v[j].x, v[j].y) | ((unsigned long long)pk2(v[j].z, v[j].w) << 32);
                const float rstd = rsqrtf(s * (1.f / D) + RMS_EPS);
                float acc[16];
#pragma unroll
                for (int h = 0; h < 16; ++h) { float d = 0.f;
#pragma unroll
                    for (int j = 0; j < 4; ++j) { const f32x4 w = *(const LAS f32x4*)(gwl + h * 1024 + 256 * j + 4 * lane); d += (v[j].x * w.x + v[j].y * w.y) + (v[j].z * w.z + v[j].w * w.w); }
                    acc[h] = d; if ((h & 3) == 3) asm volatile("" ::: "memory"); }
#pragma unroll
                for (int i = 0; i < 8; ++i) { const bool up = (lane & 32) != 0; const float keep = up ? acc[i + 8] : acc[i], send = up ? acc[i] : acc[i + 8]; acc[i] = keep + __shfl_xor(send, 32); }
#pragma unroll
                for (int i = 0; i < 4; ++i) { const bool up = (lane & 16) != 0; const float keep = up ? acc[i + 4] : acc[i], send = up ? acc[i] : acc[i + 4]; acc[i] = keep + __shfl_xor(send, 16); }
#pragma unroll
                for (int i = 0; i < 2; ++i) { const bool up = (lane & 8) != 0; const float keep = up ? acc[i + 2] : acc[i], send = up ? acc[i] : acc[i + 2]; acc[i] = keep + __shfl_xor(send, 8); }
                { const bool up = (lane & 4) != 0; const float keep = up ? acc[1] : acc[0], send = up ? acc[0] : acc[1]; acc[0] = keep + __shfl_xor(send, 4); }
                acc[0] += __shfl_xor(acc[0], 2); acc[0] += __shfl_xor(acc[0], 1);
                if ((lane & 3) == 0) { const int h = ((lane >> 5) & 1) * 8 + ((lane >> 4) & 1) * 4 + ((lane >> 3) & 1) * 2 + ((lane >> 2) & 1);
                    const float z = acc[0] * rstd + b_f[h]; const float ls = fminf(z, 0.f) - log1pf(expf(-fabsf(z)));
                    lf[(size_t)((m >> 13) * 16 + h) * SEQ + (m & (SEQ - 1))] = ls; }
#pragma unroll
                for (int j = 0; j < 4; ++j) v[j] = vn[j];
            }
        }
        for (int idx = bx * (NWAVES * 64) + tid; idx < SEQ * 32; idx += G * NWAVES * 64) { const int pos = idx >> 5, i = idx & 31;
            const float inv = exp2f(-(float)i * (13.287712379549449f / 32.f)); const float ang = (float)pos * inv;
            double rv = (double)ang * 0.15915494309189535; rv -= __builtin_rint(rv); const float fr = (float)rv;
            rope[2 * idx] = __builtin_amdgcn_cosf(fr); rope[2 * idx + 1] = __builtin_amdgcn_sinf(fr); }
        __syncthreads();
        LAS float* scr = (LAS float*)(lds + wave * 16384);
        constexpr int I0 = 16 * 96, I1 = 16 * 32, I2 = 16 * 24, I3 = 4 * 64, I4 = 6 * 48, I5 = 16 * 32, I6 = 16 * 128, I8 = 64 * 32;
        constexpr int NIT = I0 + I1 + I2 + I3 + I4 + I5 + 2 * I6 + 2 * I8;
        for (int it = gw; it < NIT; it += NGW) { int r = it; const int nl = lane & 31;
#define TR_PLAIN(Wp, ldw_, gp, K_, nblk_, dst_) do { const int k0_ = 64 * (r / (nblk_)), n0_ = 32 * (r % (nblk_)); tr_item2((Wp), (ldw_), n0_ + nl, (gp), (K_), k0_, n0_, (bf16*)(ws + (dst_)), scr, lane); } while (0)
            if (r < I0) { TR_PLAIN(w_fin, 3088, g_mix, 1024, 96, W_FIN); continue; } r -= I0;
            if (r < I1) { TR_PLAIN(w_fout, 1024, nullptr, 1024, 32, W_FOUT); continue; } r -= I1;
            if (r < I2) { const int k0_ = 64 * (r / 24), n0_ = 32 * (r % 24), n_ = n0_ + nl;
                if (n0_ < 256) tr_item2(w_kva, 320, n_, g_kv, 1024, k0_, n0_, (bf16*)(ws + W_QKVA), scr, lane);
                else if (n0_ < 640) tr_item2(w_qa, 384, n_ - 256, g_mix + D, 1024, k0_, n0_, (bf16*)(ws + W_QKVA), scr, lane);
                else if (n0_ < 704) { const int c2 = n_ - 640; tr_item2(w_kva, 320, 256 + (c2 >> 1) + 32 * (c2 & 1), g_kv, 1024, k0_, n0_, (bf16*)(ws + W_QKVA), scr, lane); }
                else tr_item2(w_kva, 320, -1, nullptr, 1024, k0_, n0_, (bf16*)(ws + W_QKVA), scr, lane);
                continue; } r -= I2;
            if (r < I3) { TR_PLAIN(w_kvb, 2048, g_kva, 256, 64, W_KVB); continue; } r -= I3;
            if (r < I4) { const int k0_ = 64 * (r / 48), n0_ = 32 * (r % 48), n_ = n0_ + nl; int src;
                if (n_ < 1024) src = (n_ >> 7) * 192 + (n_ & 127); else { const int q_ = n_ - 1024; src = (q_ >> 6) * 192 + 128 + ((q_ & 63) >> 1) + 32 * (q_ & 1); }
                tr_item2(w_qb, 1536, src, g_qa, 384, k0_, n0_, (bf16*)(ws + W_QB), scr, lane); continue; } r -= I4;
            if (r < I5) { if (!panel_mode) TR_PLAIN(w_mout, 1024, nullptr, 1024, 32, W_MOUT); continue; } r -= I5;
            if (r < I6) { TR_PLAIN(w_up, 4096, g_ffn, 1024, 128, W_UP0); continue; } r -= I6;
            if (r < I6) { if (!panel_mode) TR_PLAIN(w_up + (size_t)D * FF, 4096, g_ffn + D, 1024, 128, W_UP1); continue; } r -= I6;
            if (r < I8) { TR_PLAIN(w_dn, 1024, nullptr, 4096, 32, W_DN0); continue; } r -= I8;
            if (!panel_mode) TR_PLAIN(w_dn + (size_t)FF * D, 1024, nullptr, 4096, 32, W_DN1);
        }
        __syncthreads();
    }
    SEAM(0);
    if (IN(1)) for (int rep_ = 0; rep_ < (PROBE_PH == 1 ? 2 : 1); ++rep_) { TID_INIT();
        LAS double* red = (LAS double*)lds;
        for (int w = bx; w < 256; w += G) { const int bh = w >> 3, ch = w & 7; const float* src = lf + (size_t)bh * SEQ;
            double p = 0.0; { float pv_[14];
#pragma unroll
                for (int k = 0; k < 14; ++k) { const int i = tid + k * (NWAVES * 64); pv_[k] = i < ch * 1024 ? src[i] : 0.f; }
#pragma unroll
                for (int k = 0; k < 14; ++k) p += (double)pv_[k]; }
            p = wave_sum_d(p); if (lane == 0) red[wave] = p;
            __syncthreads();
            double pre = 0.0;
#pragma unroll
            for (int k = 0; k < 8; ++k) pre += red[k];
            const float a = src[ch * 1024 + 2 * tid], b = src[ch * 1024 + 2 * tid + 1]; const double s2 = (double)a + (double)b;
            double inc = s2;
#pragma unroll
            for (int o = 1; o < 64; o <<= 1) { const int thi = __shfl_up(__double2hiint(inc), o), tlo = __shfl_up(__double2loint(inc), o); if (lane >= o) inc += __hiloint2double(thi, tlo); }
            if (lane == 63) red[8 + wave] = inc;
            __syncthreads();
            double woff = 0.0;
#pragma unroll
            for (int k = 0; k < 8; ++k) if (k < wave) woff += red[8 + k];
            const double excl = pre + woff + inc - s2;
            cc[(size_t)bh * SEQ + ch * 1024 + 2 * tid] = excl + (double)a; cc[(size_t)bh * SEQ + ch * 1024 + 2 * tid + 1] = excl + s2;
            __syncthreads();
        }
        pg8::Gemm g{XB, (const bf16*)(ws + W_FIN), M, 3072, 1024}; pg8::StaticOrder S; S.init(M, 3072, G, bx);
        pg8::EpiQKV E{FQB, (size_t)M * 1024, FVB, SS(SS0), C2_FOX, (unsigned*)(ws + WS_CTL + 512 * 1024)};
        pg8::gemm_phase<pg8::EpiQKV, pg8::StaticOrder, true, true>((LAS unsigned char*)lds, g, S, E);
    }
    SEAM(1);
    if (panel_mode) {
        if (threadIdx.x == 0) { const unsigned mine = __hip_atomic_load(gctl + bx, __ATOMIC_RELAXED, __HIP_MEMORY_SCOPE_AGENT); unsigned same = 1u;
#pragma unroll
            for (int m_ = 0; m_ < 4; ++m_) same &= (__hip_atomic_load(gctl + 8 * ((g_pm & 7) + 8 * m_) + (g_pm >> 3), __ATOMIC_RELAXED, __HIP_MEMORY_SCOPE_AGENT) == mine) ? 1u : 0u;
            ((LAS unsigned*)(lds + 131072))[16] = same; }
        __syncthreads();
        same_l2 = ((LAS unsigned*)(lds + 131072))[16] != 0u;
    }
    if (IN(2)) {
        for (int i = 0, idx = vcu; panel_mode ? i < 4 : idx < 1024; ++i, idx += G) { int bh, qb;
            if (panel_mode) { bh = (g_pm >> 5) * 16 + 4 * g_mem + i; qb = g_pm & 31; }
            else { const int k4 = idx >> 8, v = idx & 255, s_ = v & 7; bh = v >> 3; qb = (k4 == 0) ? s_ : (k4 == 1) ? 15 - s_ : (k4 == 2) ? 16 + s_ : 31 - s_; }
            const int b = bh >> 4, h = bh & 15;
            att::Unit U; const size_t ro = (size_t)b * SEQ * 1024 + h * 64;
            U.q[0] = FQB + ro; U.q[1] = U.q[0]; U.qs = 1024;
            U.kA = FKB + ro; U.ksA = 1024; U.kB = U.kA; U.ksB = 1024;
            U.v = FVB + ro; U.vs = 1024;
            U.o = FQB + ro; U.os = 1024; U.c = cc + (size_t)bh * SEQ; U.rtab = nullptr; U.kmax2 = (const unsigned*)(ws + WS_CTL + 512 * 1024) + bh * 2; U.q0 = qb * 256; U.j_lo = 0;
            att::attn_unit<64, 64, true>(U, (char*)lds);
        }
    }
    GARRIVE(2);
    if (IN(3)) {
        pg8::Gemm g{FQB, (const bf16*)(ws + W_FOUT), M, 1024, 1024}; FLEXW(S, 1024, 2);
        pg8::EpiRes E{STREAM_LO ? x_in : (const float*)nullptr, XB, LOB, SS(SS1)};
        pg8::gemm_phase<pg8::EpiRes, pg8::FlexOrder, true, true>((LAS unsigned char*)lds, g, S, E);
    }
    GARRIVE(3);
    if (IN(4)) for (int rep_ = 0; rep_ < (PROBE_PH == 4 ? 2 : 1); ++rep_) {
        pg8::Gemm g{XB, (const bf16*)(ws + W_UP0), M, 4096, 1024}; FLEXW(S, 4096, 3);
        pg8::EpiUp E{HB, SS(SS1)};
        pg8::gemm_phase<pg8::EpiUp, pg8::FlexOrder, true, true>((LAS unsigned char*)lds, g, S, E);
    }
    GARRIVE(4);
    if (IN(5)) {
        pg8::Gemm g{HB, (const bf16*)(ws + W_DN0), M, 1024, 4096}; FLEXW(S, 1024, 4);
        pg8::EpiRes E{nullptr, XB, LOB, SS(SS2)};
        pg8::gemm_phase<pg8::EpiRes, pg8::FlexOrder, true, true>((LAS unsigned char*)lds, g, S, E);
    }
    GSEAM(5);
    if (IN(6) && panel_mode) {
        if (threadIdx.x == 0) { const int dep[3] = {g_pm >> 2, (4096 + 96 * g_pm) >> 8, (4096 + 96 * g_pm + 95) >> 8};
#pragma unroll
            for (int d_ = 0; d_ < 3; ++d_) { const unsigned* c_ = gctl + 1024 + (3 * 64 + dep[d_]) * 16; unsigned sp = 0u;
                while (__hip_atomic_load(c_, __ATOMIC_RELAXED, __HIP_MEMORY_SCOPE_AGENT) < 4u) { __builtin_amdgcn_s_sleep(1); if (++sp > (1u << 22)) break; } } }
        __syncthreads();
    }
    if (IN(6)) {
        if (panel_mode && g_mem == 3) { TID_INIT();
            LAS float* scr = (LAS float*)(lds + wave * 16384); const int nl = lane & 31;
            for (int it = g_pm * NWAVES + wave; it < 512 + 2048 + 2048; it += 64 * NWAVES) { int r = it;
                if (r < 512) { TR_PLAIN(w_mout, 1024, nullptr, 1024, 32, W_MOUT); continue; } r -= 512;
                if (r < 2048) { TR_PLAIN(w_up + (size_t)D * FF, 4096, g_ffn + D, 1024, 128, W_UP1); continue; } r -= 2048;
                TR_PLAIN(w_dn + (size_t)FF * D, 1024, nullptr, 4096, 32, W_DN1); }
            __syncthreads();
        }
        pg8::Gemm g{XB, (const bf16*)(ws + W_QKVA), M, 768, 1024}; FLEX(S, 768);
        pg8::EpiQKVA E{CKVB, QAB, (bf16*)(ws + WS_MKR), SS(SS2), SS(SSKV), SS(SSQ), rope};
        pg8::gemm_phase<pg8::EpiQKVA, pg8::FlexOrder, true, true>((LAS unsigned char*)lds, g, S, E);
    }
    GSEAM(6);
    if (IN(7) && panel_mode) {
        if (threadIdx.x == 0) { const int dep[3] = {g_pm >> 1, (256 + 3 * g_pm) >> 3, (258 + 3 * g_pm) >> 3};
#pragma unroll
            for (int d_ = 0; d_ < 3; ++d_) { const unsigned* c_ = gctl + 1024 + (5 * 64 + dep[d_]) * 16; unsigned sp = 0u;
                while (__hip_atomic_load(c_, __ATOMIC_RELAXED, __HIP_MEMORY_SCOPE_AGENT) < 4u) { __builtin_amdgcn_s_sleep(1); if (++sp > (1u << 22)) break; } } }
        __syncthreads();
    }
    if (IN(7)) for (int rep_ = 0; rep_ < (PROBE_PH == 7 ? 2 : 1); ++rep_) {
        { pg8::Gemm g{CKVB, (const bf16*)(ws + W_KVB), M, 2048, 256}; FLEX(S, 2048);
          pg8::EpiKVB E{(bf16*)(ws + WS_MKV), SS(SSKV)};
          pg8::gemm_phase<pg8::EpiKVB, pg8::FlexOrder, true, true>((LAS unsigned char*)lds, g, S, E); }
        { pg8::Gemm g{QAB, (const bf16*)(ws + W_QB), M, 1536, 384}; FLEX(S, 1536);
          pg8::EpiQB E{(bf16*)(ws + WS_MQ), SS(SSQ), C2_MLA};
          pg8::gemm_phase<pg8::EpiQB, pg8::FlexOrder, false, true>((LAS unsigned char*)lds, g, S, E); }
    }
    SEAM(7);
    if (IN(8)) for (int rep_ = 0; rep_ < (PROBE_PH == 8 ? 2 : 1); ++rep_) {
        for (int i = vcu; i < 512; i += G) { const int k2 = i >> 8, v = i & 255, bh = v >> 4, s = v & 15, b = bh >> 3, h = bh & 7;
            const int qb = (k2 == 0) ? 31 - s : s;
            att::Unit U; const size_t rq = (size_t)b * SEQ * 1536, rk = (size_t)b * SEQ * 2048;
            U.q[0] = (const bf16*)(ws + WS_MQ) + rq + h * 128; U.q[1] = (const bf16*)(ws + WS_MQ) + rq + 1024 + h * 64; U.qs = 1536;
            U.kA = (const bf16*)(ws + WS_MKV) + rk + h * 256; U.ksA = 2048; U.kB = (const bf16*)(ws + WS_MKR) + (size_t)b * SEQ * 64; U.ksB = 64;
            U.v = (const bf16*)(ws + WS_MKV) + rk + h * 256 + 128; U.vs = 2048;
            U.o = (bf16*)(ws + WS_MO) + (size_t)b * SEQ * 1024 + h * 128; U.os = 1024; U.c = nullptr; U.kmax2 = nullptr; U.rtab = rope; U.q0 = qb * 256; U.j_lo = 0;
            att::attn_unit<192, 128, false>(U, (char*)lds);
        }
    }
    SEAM(8);
    if (IN(9)) {
        pg8::Gemm g{(const bf16*)(ws + WS_MO), (const bf16*)(ws + W_MOUT), M, 1024, 1024}; FLEX(S, 1024);
        pg8::EpiRes E{nullptr, XB, LOB, SS(SS3)};
        pg8::gemm_phase<pg8::EpiRes, pg8::FlexOrder, true, true>((LAS unsigned char*)lds, g, S, E);
    }
    GARRIVE(9);
    if (IN(10)) {
        pg8::Gemm g{XB, (const bf16*)(ws + W_UP1), M, 4096, 1024}; FLEXW(S, 4096, 9);
        pg8::EpiUp E{HB, SS(SS3)};
        pg8::gemm_phase<pg8::EpiUp, pg8::FlexOrder, true, true>((LAS unsigned char*)lds, g, S, E);
    }
    GARRIVE(10);
    if (IN(11)) {
        pg8::Gemm g{HB, (const bf16*)(ws + W_DN1), M, 1024, 4096}; FLEXW(S, 1024, 10);
        if (G == 256) {
            pg8::EpiResFinal E{XB, LOB, out, SS(SS4), g_fin, (unsigned*)(ws + WS_CTL + 40960)};
            pg8::gemm_phase<pg8::EpiResFinal, pg8::FlexOrder, false, true>((LAS unsigned char*)lds, g, S, E);
        } else {
            pg8::EpiRes E{nullptr, XB, LOB, SS(SS4)};
            pg8::gemm_phase<pg8::EpiRes, pg8::FlexOrder, true, true>((LAS unsigned char*)lds, g, S, E);
            xcd_barrier(xbar);
            TID_INIT();
            if (wave == 0) for (int pm_ = bx; pm_ < M / 256; pm_ += G) for (int rr = 255; rr >= 0; --rr) { const int m = pm_ * 256 + rr;
                const float rstd = rsqrtf(SS(SS4)[m] * (1.f / D) + RMS_EPS); f32x4 v[4];
#pragma unroll
                for (int j = 0; j < 4; ++j) { const size_t e = (size_t)m * D + 256 * j + 4 * lane; const unsigned long long hw = *(const unsigned long long*)(XB + e), lw = STREAM_LO ? *(const unsigned long long*)((const bf16*)out + (size_t)pm_ * 262144 + e) : 0ull;
                    v[j].x = __uint_as_float((unsigned)hw << 16) + __uint_as_float((unsigned)lw << 16); v[j].y = __uint_as_float((unsigned)hw & 0xffff0000u) + __uint_as_float((unsigned)lw & 0xffff0000u);
                    v[j].z = __uint_as_float((unsigned)(hw >> 32) << 16) + __uint_as_float((unsigned)(lw >> 32) << 16); v[j].w = __uint_as_float((unsigned)(hw >> 32) & 0xffff0000u) + __uint_as_float((unsigned)(lw >> 32) & 0xffff0000u); }
                asm volatile("s_waitcnt vmcnt(0)" ::: "memory");
#pragma unroll
                for (int j = 0; j < 4; ++j) *((f32x4*)(out + (size_t)m * D) + 64 * j + lane) = v[j] * rstd * *((const f32x4*)g_fin + 64 * j + lane);
                asm volatile("s_waitcnt vmcnt(0)" ::: "memory"); }
        }
    }
#undef TR_PLAIN
#undef IN
#undef SEAM
#undef GSEAM
#undef FLEX
#undef FLEXW
#undef GARRIVE
#undef SS
#undef x_in
#undef g_mix
#undef g_ffn
#undef w_fin
#undef b_f
#undef w_fout
#undef g_kv
#undef w_kva
#undef g_kva
#undef w_kvb
#undef w_qa
#undef g_qa
#undef w_qb
#undef w_mout
#undef w_up
#undef w_dn
#undef g_fin
#undef out
#undef ws
#undef rope
#undef lf
#undef cc
#undef XB
#undef FQB
#undef FKB
#undef FVB
#undef CKVB
#undef QAB
#undef LOB
#undef HB
#undef ssb
}

constexpr int N_PHASES = 12;
#ifndef MK_PER_PHASE
#define MK_PER_PHASE 0
#endif
extern "C" void kernel_launch(void* const* d_in, const int* in_sizes, int n_in, void* d_out, int out_size, void* d_ws, size_t ws_size, hipStream_t stream) {
    static int grid = 0;
    if (grid == 0) {
        if (n_in != 17 || in_sizes[0] != M * D || out_size != M * D || ws_size < WS_END) { fprintf(stderr, "kernel_launch: unexpected shapes (n_in %d, in0 %d, out %d, ws %zu)\n", n_in, n_in > 0 ? in_sizes[0] : -1, out_size, ws_size); grid = -1; return; }
        int dev = 0, cus = 0, per_cu = 0;
        if (hipGetDevice(&dev) != hipSuccess || hipDeviceGetAttribute(&cus, hipDeviceAttributeMultiprocessorCount, dev) != hipSuccess) { grid = -1; return; }
        if (hipFuncSetAttribute((const void*)yoco_fwd, hipFuncAttributeMaxDynamicSharedMemorySize, LDS_BYTES) != hipSuccess) { fprintf(stderr, "kernel_launch: hipFuncSetAttribute failed\n"); grid = -1; return; }
        if (hipOccupancyMaxActiveBlocksPerMultiprocessor(&per_cu, (const void*)yoco_fwd, NWAVES * 64, LDS_BYTES) != hipSuccess || per_cu < 1) { fprintf(stderr, "kernel_launch: occupancy query says %d\n", per_cu); per_cu = 1; }
        (void)hipGetLastError();
        grid = cus * per_cu;
    }
    if (grid < 0) return;
    (void)hipMemsetAsync((char*)d_ws + WS_CTL, 0, CTL_ZERO_BYTES, stream);
    Args a{};
    for (int i = 0; i < 17; ++i) a.in[i] = (const float*)d_in[i];
    a.out = (float*)d_out; a.ws = (unsigned char*)d_ws;
#if MK_PER_PHASE
    for (int p = 0; p < N_PHASES; ++p) { a.ph_lo = p; a.ph_hi = p + 1; hipLaunchKernelGGL(yoco_fwd, dim3(grid), dim3(NWAVES * 64), LDS_BYTES, stream, a); }
#else
    a.ph_lo = 0; a.ph_hi = N_PHASES;
    void* kargs[] = {&a};
    hipError_t e = hipLaunchCooperativeKernel((const void*)yoco_fwd, dim3(grid), dim3(NWAVES * 64), kargs, LDS_BYTES, stream);
    if (e != hipSuccess) fprintf(stderr, "kernel_launch: cooperative launch failed: %s (grid %d)\n", hipGetErrorString(e), grid);
#endif
}
```

```cpp
#include <hip/hip_runtime.h>
#include <hip/hip_cooperative_groups.h>
#include <cstdio>
#include <cstdint>
namespace cg = cooperative_groups;
namespace pg8 {
#define PG8_LAS __attribute__((address_space(3)))
typedef unsigned short bf16_t;
typedef short bf16x8 __attribute__((ext_vector_type(8)));
typedef float f32x4 __attribute__((ext_vector_type(4)));
typedef unsigned u32x4 __attribute__((ext_vector_type(4)));
constexpr int BM = 256, BK = 64, HALF = 128, HTB = HALF * BK * 2  , STAGE_BYTES = 8 * HTB, NXCD = 8, WGM = 8;

__host__ __device__ __forceinline__ int lds_byte(int r, int c) { const int st = (r >> 4) * 2 + (c >> 5), rr = r & 15, cc = c & 31, ob = rr * 64 + cc * 2; return st * 1024 + (ob ^ (((ob >> 9) & 1) << 5)); }
__host__ __device__ __forceinline__ void stage_rc(int b, int& R, int& C) { const int st = b / 1024, sb = b % 1024, swz = sb ^ (((sb >> 9) & 1) << 5); R = (st >> 1) * 16 + swz / 64; C = (st & 1) * 32 + (swz % 64) / 2; }
__host__ __device__ __forceinline__ int perm32(int rho) { const int n = rho >> 4, i = rho & 15; return 8 * (i >> 2) + 4 * n + (i & 3); }

struct Unit { int pm, pn; };
struct Gemm { const bf16_t* A; const bf16_t* Bt; int M, N, K; };

struct StaticOrder {
    int nM, nN, nwg, G, c;
    __host__ __device__ void init(int M, int N, int G_, int c_) { nM = M / BM; nN = N / BM; nwg = nM * nN; G = G_; c = c_; }
    __host__ __device__ bool next(int i, Unit& u) const {
        const long L = (long)i * G + c; if (L >= nwg) return false;
        int wgid = (int)L; { const int q = nwg / NXCD, r = nwg % NXCD, xcd = wgid % NXCD, off = wgid / NXCD; wgid = (xcd < r ? xcd * (q + 1) : r * (q + 1) + (xcd - r) * q) + off; }
        const int nig = WGM * nN, gid = wgid / nig, fm = gid * WGM, gsz = (nM - fm) < WGM ? (nM - fm) : WGM;
        u.pm = fm + ((wgid % nig) % gsz); u.pn = (wgid % nig) / gsz; return true;
    }
    __device__ __forceinline__ void a_ready(const Unit&) const {}
    __device__ __forceinline__ void done(const Unit&) const {}
};

__device__ __forceinline__ unsigned cvt_pk_bf16(float lo, float hi) { unsigned r; asm volatile("v_cvt_pk_bf16_f32 %0, %1, %2" : "=v"(r) : "v"(lo), "v"(hi)); return r; }
typedef float f32x2 __attribute__((ext_vector_type(2)));
template <class Epi, class Sched, bool ALIGN_EPI = false, bool SP2 = false>
__device__ __forceinline__ void gemm_phase(PG8_LAS unsigned char* lds, const Gemm g, const Sched& S, const Epi& E) {
    int tid_ = threadIdx.x; asm volatile("" : "+v"(tid_));
    const int tid = tid_, wid = __builtin_amdgcn_readfirstlane(tid >> 6), lane = tid & 63, wr = wid >> 2, wc = wid & 3, fr = lane & 15, fq = lane >> 4;
    const int K = g.K, nt = K / BK;
    unsigned voffA[2], voffB[2];
#pragma unroll
    for (int i = 0; i < 2; ++i) { int R, C; stage_rc(tid * 16 + i * 8192, R, C); const int Rb = Epi::PERM ? ((R & ~31) + perm32(R & 31)) : R;
        voffA[i] = (unsigned)(R * K + C) * 2u; voffB[i] = (unsigned)(Rb * K + C) * 2u; }
    const size_t kstep = (size_t)(BK * 2);
    const size_t hstep = (size_t)HALF * K * 2;
    const size_t tstep = 2 * hstep;
    const unsigned ldsw = (unsigned)wid * 1024u;
    const int aoff = lds_byte(wr * 64 + fr, fq * 8), boff = lds_byte(wc * 32 + fr, fq * 8);
#define PG8_SA(b, h) (((b) * 2 + (h)) * HTB)
#define PG8_SB(b, h) ((4 + (b) * 2 + (h)) * HTB)
#define PG8_STAGE(bufoff, gbase, voff) do { _Pragma("unroll") for (int _i = 0; _i < 2; ++_i) \
        __builtin_amdgcn_global_load_lds((const unsigned*)((const char*)(gbase) + (voff)[_i]), (PG8_LAS unsigned*)(lds + (bufoff) + ldsw + _i * 8192), 16, 0, 0); } while (0)
#define PG8_LDA(dst, b, h) do { _Pragma("unroll") for (int m = 0; m < 4; ++m) _Pragma("unroll") for (int k = 0; k < 2; ++k) dst[m][k] = *(const PG8_LAS bf16x8*)(lds + PG8_SA(b, h) + aoff + m * 2048 + k * 1024); } while (0)
#define PG8_LDB(dst, b, h) do { _Pragma("unroll") for (int n = 0; n < 2; ++n) _Pragma("unroll") for (int k = 0; k < 2; ++k) dst[n][k] = *(const PG8_LAS bf16x8*)(lds + PG8_SB(b, h) + boff + n * 2048 + k * 1024); } while (0)
#define PG8_MMA(ai, bj, At, Bt) do { __builtin_amdgcn_s_setprio(1); _Pragma("unroll") for (int m = 0; m < 4; ++m) _Pragma("unroll") for (int n = 0; n < 2; ++n) _Pragma("unroll") for (int k = 0; k < 2; ++k) \
        acc[ai][bj][m][n] = __builtin_amdgcn_mfma_f32_16x16x32_bf16(Bt[n][k], At[m][k], acc[ai][bj][m][n], 0, 0, 0); __builtin_amdgcn_s_setprio(0); } while (0)
#define PG8_WAIT_V(n) asm volatile("s_waitcnt vmcnt(" #n ")" ::: "memory")
#define PG8_WAIT_L(n) asm volatile("s_waitcnt lgkmcnt(" #n ")" ::: "memory")
#define PG8_BAR __builtin_amdgcn_s_barrier()
#define PG8_SCHED __builtin_amdgcn_sched_barrier(0)
    Unit cur, nxt; int ui = 0;
    if (!S.next(0, cur)) return;
    f32x4 acc[2][2][4][2];
#pragma unroll
    for (int a = 0; a < 2; ++a)
#pragma unroll
        for (int b = 0; b < 2; ++b)
#pragma unroll
            for (int m = 0; m < 4; ++m)
#pragma unroll
                for (int n = 0; n < 2; ++n) acc[a][b][m][n] = (f32x4){0.f, 0.f, 0.f, 0.f};
    bf16x8 At[4][2], B0[2][2], B1[2][2];
    const char* cA = (const char*)g.A + (size_t)cur.pm * tstep; const char* cB = (const char*)g.Bt + (size_t)cur.pn * tstep;
    if constexpr (!SP2) S.a_ready(cur);
    if constexpr (SP2) {
        PG8_STAGE(PG8_SB(0, 0), cB, voffB); PG8_STAGE(PG8_SB(0, 1), cB + hstep, voffB);
        S.a_ready(cur);
        PG8_STAGE(PG8_SA(0, 0), cA, voffA); PG8_STAGE(PG8_SA(0, 1), cA + hstep, voffA);
        if (wr == 1) PG8_BAR;
        PG8_WAIT_V(2); PG8_BAR;
        PG8_STAGE(PG8_SB(1, 0), cB + kstep, voffB); PG8_STAGE(PG8_SA(1, 0), cA + kstep, voffA); PG8_STAGE(PG8_SB(1, 1), cB + hstep + kstep, voffB);
        PG8_WAIT_V(6); PG8_BAR;
    } else {
        PG8_STAGE(PG8_SB(0, 0), cB, voffB); PG8_STAGE(PG8_SA(0, 0), cA, voffA); PG8_STAGE(PG8_SB(0, 1), cB + hstep, voffB); PG8_STAGE(PG8_SA(0, 1), cA + hstep, voffA);
        if (wr == 1) PG8_BAR;
        PG8_WAIT_V(4); PG8_BAR;
        PG8_STAGE(PG8_SB(1, 0), cB + kstep, voffB); PG8_STAGE(PG8_SA(1, 0), cA + kstep, voffA); PG8_STAGE(PG8_SB(1, 1), cB + hstep + kstep, voffB);
        PG8_WAIT_V(6); PG8_BAR;
    }
    for (;;) {
        const bool has_next = S.next(ui + 1, nxt);
        const char* nA = has_next ? (const char*)g.A + (size_t)nxt.pm * tstep : cA; const char* nB = has_next ? (const char*)g.Bt + (size_t)nxt.pn * tstep : cB;
#pragma unroll 1
        for (int t = 0; t < nt; t += 2) {
            const bool last = (t == nt - 2);
            const char* a1 = cA + (size_t)(t + 1) * kstep;
            const char* a2 = last ? nA : cA + (size_t)(t + 2) * kstep; const char* b2 = last ? nB : cB + (size_t)(t + 2) * kstep;
            const char* a3 = a2 + kstep; const char* b3 = b2 + kstep;
            if (last && has_next) S.a_ready(nxt);
            if constexpr (SP2) {
            PG8_LDB(B0, 0, 0); PG8_LDB(B1, 0, 1); PG8_SCHED; PG8_LDA(At, 0, 0); PG8_STAGE(PG8_SA(1, 1), a1 + hstep, voffA);
            PG8_WAIT_V(8); PG8_WAIT_L(0); PG8_BAR; PG8_MMA(0, 0, At, B0); PG8_MMA(0, 1, At, B1); PG8_BAR; PG8_SCHED;
            PG8_LDA(At, 0, 1); PG8_STAGE(PG8_SB(0, 0), b2, voffB); PG8_STAGE(PG8_SB(0, 1), b2 + hstep, voffB); PG8_STAGE(PG8_SA(0, 0), a2, voffA);
            PG8_WAIT_V(8); PG8_WAIT_L(0); PG8_BAR; PG8_MMA(1, 0, At, B0); PG8_MMA(1, 1, At, B1); PG8_BAR; PG8_SCHED;
            PG8_LDB(B0, 1, 0); PG8_LDB(B1, 1, 1); PG8_SCHED; PG8_LDA(At, 1, 0); PG8_STAGE(PG8_SA(0, 1), a2 + hstep, voffA);
            PG8_WAIT_V(8); PG8_WAIT_L(0); PG8_BAR; PG8_MMA(0, 0, At, B0); PG8_MMA(0, 1, At, B1); PG8_BAR; PG8_SCHED;
            PG8_LDA(At, 1, 1); PG8_STAGE(PG8_SB(1, 0), b3, voffB); PG8_STAGE(PG8_SB(1, 1), b3 + hstep, voffB); PG8_STAGE(PG8_SA(1, 0), a3, voffA);
            PG8_WAIT_V(8); PG8_WAIT_L(0); PG8_BAR; PG8_MMA(1, 0, At, B0); PG8_MMA(1, 1, At, B1); PG8_BAR; PG8_SCHED;
            } else {
            PG8_LDB(B0, 0, 0); PG8_SCHED; PG8_LDA(At, 0, 0); PG8_STAGE(PG8_SA(1, 1), a1 + hstep, voffA);
            PG8_WAIT_L(8); PG8_BAR; PG8_WAIT_L(0); PG8_MMA(0, 0, At, B0); PG8_BAR; PG8_SCHED;
            PG8_LDB(B1, 0, 1); PG8_STAGE(PG8_SB(0, 0), b2, voffB);
            PG8_BAR; PG8_WAIT_L(0); PG8_MMA(0, 1, At, B1); PG8_BAR;
            PG8_LDA(At, 0, 1); PG8_STAGE(PG8_SA(0, 0), a2, voffA);
            PG8_BAR; PG8_WAIT_L(0); PG8_MMA(1, 0, At, B0); PG8_BAR; PG8_SCHED;
            PG8_STAGE(PG8_SB(0, 1), b2 + hstep, voffB);
            PG8_WAIT_V(6); PG8_BAR; PG8_MMA(1, 1, At, B1); PG8_BAR;
            PG8_LDB(B0, 1, 0); PG8_SCHED; PG8_LDA(At, 1, 0); PG8_STAGE(PG8_SA(0, 1), a2 + hstep, voffA);
            PG8_WAIT_L(8); PG8_BAR; PG8_WAIT_L(0); PG8_MMA(0, 0, At, B0); PG8_BAR; PG8_SCHED;
            PG8_LDB(B1, 1, 1); PG8_STAGE(PG8_SB(1, 0), b3, voffB);
            PG8_BAR; PG8_WAIT_L(0); PG8_MMA(0, 1, At, B1); PG8_BAR;
            PG8_LDA(At, 1, 1); PG8_STAGE(PG8_SA(1, 0), a3, voffA);
            PG8_BAR; PG8_WAIT_L(0); PG8_MMA(1, 0, At, B0); PG8_BAR; PG8_SCHED;
            PG8_STAGE(PG8_SB(1, 1), b3 + hstep, voffB);
            PG8_WAIT_V(6); PG8_BAR; PG8_MMA(1, 1, At, B1); PG8_BAR;
            }
        }
        if constexpr (ALIGN_EPI) { if (wr == 0) PG8_BAR; }
        if constexpr (!Epi::AFTER_DRAIN) { E(acc, cur, wr, wc, fr, fq); S.done(cur); }
        if (!has_next) break;
#pragma unroll
        for (int a = 0; a < 2; ++a)
#pragma unroll
            for (int b = 0; b < 2; ++b)
#pragma unroll
                for (int m = 0; m < 4; ++m)
#pragma unroll
                    for (int n = 0; n < 2; ++n) acc[a][b][m][n] = (f32x4){0.f, 0.f, 0.f, 0.f};
        cur = nxt; cA = nA; cB = nB; ++ui;
        if constexpr (ALIGN_EPI) { if (wr == 1) PG8_BAR; }
    }
    PG8_WAIT_V(0);
    if constexpr (!ALIGN_EPI) { if (wr == 0) PG8_BAR; }
    PG8_BAR;
    if constexpr (Epi::AFTER_DRAIN) { E.fused(acc, cur, wr, wc, fr, fq, lds, wid, lane); S.done(cur); }
#undef PG8_SA
#undef PG8_SB
#undef PG8_STAGE
#undef PG8_LDA
#undef PG8_LDB
#undef PG8_MMA
#undef PG8_WAIT_V
#undef PG8_WAIT_L
#undef PG8_BAR
#undef PG8_SCHED
}
}
namespace pg8 {
typedef unsigned u32x2 __attribute__((ext_vector_type(2)));
constexpr float RMS_EPS = 1e-6f;
__device__ __forceinline__ u32x4 pack8(f32x4 a, f32x4 b) { u32x4 w; w.x = cvt_pk_bf16(a[0], a[1]); w.y = cvt_pk_bf16(a[2], a[3]); w.z = cvt_pk_bf16(b[0], b[1]); w.w = cvt_pk_bf16(b[2], b[3]); return w; }
__device__ __forceinline__ float sumsq8(f32x4 a, f32x4 b) { return (a[0] * a[0] + a[1] * a[1]) + (a[2] * a[2] + a[3] * a[3]) + (b[0] * b[0] + b[1] * b[1]) + (b[2] * b[2] + b[3] * b[3]); }
__device__ __forceinline__ void rope8(f32x4& v0, f32x4& v1, const float* tab) {
    const f32x4 t0 = *(const f32x4*)tab, t1 = *(const f32x4*)(tab + 4);
    f32x4 a, b;
    a[0] = v0[0] * t0[0] - v0[1] * t0[1]; a[1] = v0[1] * t0[0] + v0[0] * t0[1];
    a[2] = v0[2] * t0[2] - v0[3] * t0[3]; a[3] = v0[3] * t0[2] + v0[2] * t0[3];
    b[0] = v1[0] * t1[0] - v1[1] * t1[1]; b[1] = v1[1] * t1[0] + v1[0] * t1[1];
    b[2] = v1[2] * t1[2] - v1[3] * t1[3]; b[3] = v1[3] * t1[2] + v1[2] * t1[3];
    v0 = a; v1 = b;
}
__device__ __forceinline__ void row_rstd(float (&rs)[2][4], const float* ss, int row0, float invn, float mul) {
    float t[2][4];
#pragma unroll
    for (int ai = 0; ai < 2; ++ai)
#pragma unroll
        for (int m = 0; m < 4; ++m) t[ai][m] = ss[row0 + ai * HALF + m * 16];
#pragma unroll
    for (int ai = 0; ai < 2; ++ai)
#pragma unroll
        for (int m = 0; m < 4; ++m) rs[ai][m] = rsqrtf(t[ai][m] * invn + RMS_EPS) * mul;
}
__device__ __forceinline__ void row_rstd4(float (&rs)[4], const float* ss, int row0, float invn, float mul) {
    float t[4];
#pragma unroll
    for (int m = 0; m < 4; ++m) t[m] = ss[row0 + m * 16];
#pragma unroll
    for (int m = 0; m < 4; ++m) rs[m] = rsqrtf(t[m] * invn + RMS_EPS) * mul;
}
struct EpiQKV {
    static constexpr bool PERM = true, AFTER_DRAIN = false;
    bf16_t* Q; size_t tstride; bf16_t* V; const float* ss; float qscale;
    unsigned* kmax2;
    __device__ __forceinline__ void operator()(const f32x4 (&acc)[2][2][4][2], const Unit& u, int wr, int wc, int fr, int fq) const {
        const int t = u.pn >> 2; bf16_t* base = t < 2 ? Q + (size_t)t * tstride : V; const float sc = t == 0 ? qscale : 1.f;
        const int col0 = (u.pn & 3) * 256 + wc * 32 + 8 * fq;
        float rsv[2][4]; row_rstd(rsv, ss, u.pm * BM + wr * 64 + fr, 1.f / 1024.f, 1.f);
#pragma unroll
        for (int ai = 0; ai < 2; ++ai)
#pragma unroll
            for (int m = 0; m < 4; ++m) { const int row = u.pm * BM + ai * HALF + wr * 64 + m * 16 + fr; const float rs = rsv[ai][m] * sc;
                bf16_t* rowp = base + (size_t)row * 1024 + col0;
#pragma unroll
                for (int bj = 0; bj < 2; ++bj) *(u32x4*)(rowp + bj * HALF) = pack8(acc[ai][bj][m][0] * rs, acc[ai][bj][m][1] * rs); }
        if (t == 1) {
#pragma unroll
            for (int bj = 0; bj < 2; ++bj) { float mx = 0.f;
#pragma unroll
                for (int ai = 0; ai < 2; ++ai)
#pragma unroll
                    for (int m = 0; m < 4; ++m) { const float rs = rsv[ai][m];
                        float s8 = sumsq8(acc[ai][bj][m][0] * rs, acc[ai][bj][m][1] * rs); s8 += __shfl_xor(s8, 16); s8 += __shfl_xor(s8, 32); mx = fmaxf(mx, s8); }
                mx = fmaxf(mx, __shfl_xor(mx, 1)); mx = fmaxf(mx, __shfl_xor(mx, 2)); mx = fmaxf(mx, __shfl_xor(mx, 4)); mx = fmaxf(mx, __shfl_xor(mx, 8));
                if (fr == 0 && fq == 0) atomicMax(kmax2 + ((u.pm >> 5) * 16 + (u.pn & 3) * 4 + bj * 2 + (wc >> 1)) * 2 + (wc & 1), __float_as_uint(mx)); }
        }
    }
};
__device__ __forceinline__ void unpack8(const u32x4 w, f32x4& a, f32x4& b) {
    a[0] = __uint_as_float(w.x << 16); a[1] = __uint_as_float(w.x & 0xffff0000u); a[2] = __uint_as_float(w.y << 16); a[3] = __uint_as_float(w.y & 0xffff0000u);
    b[0] = __uint_as_float(w.z << 16); b[1] = __uint_as_float(w.z & 0xffff0000u); b[2] = __uint_as_float(w.w << 16); b[3] = __uint_as_float(w.w & 0xffff0000u);
}
struct EpiRes {
    static constexpr bool PERM = true, AFTER_DRAIN = false;
    const float* basef; bf16_t* xb; bf16_t* lo; float* ss;
    __device__ __forceinline__ void operator()(const f32x4 (&acc)[2][2][4][2], const Unit& u, int wr, int wc, int fr, int fq) const {
        const int col0 = u.pn * BM + wc * 32 + 8 * fq; const size_t lo_pan = (size_t)u.pm * 262144;
#pragma unroll
        for (int ai = 0; ai < 2; ++ai) {
            f32x4 bv[4][2][2];
#pragma unroll
            for (int m = 0; m < 4; ++m) { const size_t off = (size_t)(u.pm * BM + ai * HALF + wr * 64 + m * 16 + fr) * 1024 + col0;
#pragma unroll
                for (int bj = 0; bj < 2; ++bj) {
                    if (basef) { bv[m][bj][0] = *(const f32x4*)(basef + off + bj * HALF); bv[m][bj][1] = *(const f32x4*)(basef + off + bj * HALF + 4); }
                    else { const u32x4 hw = *(const u32x4*)(xb + off + bj * HALF); f32x4 h0, h1; unpack8(hw, h0, h1);
                        if (lo) { const u32x4 lw = *(const u32x4*)(lo + lo_pan + off + bj * HALF); f32x4 l0, l1; unpack8(lw, l0, l1); h0 += l0; h1 += l1; }
                        bv[m][bj][0] = h0; bv[m][bj][1] = h1; } } }
            asm volatile("" ::: "memory");
#pragma unroll
            for (int m = 0; m < 4; ++m) { const int row = u.pm * BM + ai * HALF + wr * 64 + m * 16 + fr; const size_t off = (size_t)row * 1024 + col0; float s = 0.f;
#pragma unroll
                for (int bj = 0; bj < 2; ++bj) { const size_t o2 = off + bj * HALF; const f32x4 o0 = bv[m][bj][0] + acc[ai][bj][m][0], o1 = bv[m][bj][1] + acc[ai][bj][m][1];
                    s += sumsq8(o0, o1);
                    const u32x4 hw = pack8(o0, o1); f32x4 h0, h1; unpack8(hw, h0, h1);
                    *(u32x4*)(xb + o2) = hw; if (lo) *(u32x4*)(lo + lo_pan + o2) = pack8(o0 - h0, o1 - h1); }
                s += __shfl_xor(s, 16); s += __shfl_xor(s, 32);
                if (fq == 0) atomicAdd(ss + row, s); }
            asm volatile("" ::: "memory");
        }
    }
};
struct EpiResFinal {
    static constexpr bool PERM = true, AFTER_DRAIN = true;
    const bf16_t* xb; const bf16_t* lo; float* out; float* ss; const float* g; unsigned* cnt;
    __device__ __forceinline__ void fused(f32x4 (&acc)[2][2][4][2], const Unit& u, int wr, int wc, int fr, int fq, PG8_LAS unsigned char* lds, int wid, int lane) const {
        const int col0 = u.pn * BM + wc * 32 + 8 * fq; const size_t lo_pan = (size_t)u.pm * 262144;
#pragma unroll
        for (int ai = 0; ai < 2; ++ai) {
            u32x4 hv[4][2], lv[4][2];
#pragma unroll
            for (int m = 0; m < 4; ++m) { const size_t off = (size_t)(u.pm * BM + ai * HALF + wr * 64 + m * 16 + fr) * 1024 + col0;
#pragma unroll
                for (int bj = 0; bj < 2; ++bj) { hv[m][bj] = *(const u32x4*)(xb + off + bj * HALF); lv[m][bj] = lo ? *(const u32x4*)(lo + lo_pan + off + bj * HALF) : (u32x4){0u, 0u, 0u, 0u}; } }
            asm volatile("" ::: "memory");
#pragma unroll
            for (int m = 0; m < 4; ++m) { const int row = u.pm * BM + ai * HALF + wr * 64 + m * 16 + fr; float s = 0.f;
#pragma unroll
                for (int bj = 0; bj < 2; ++bj) { f32x4 h0, h1, l0, l1; unpack8(hv[m][bj], h0, h1); unpack8(lv[m][bj], l0, l1);
                    const f32x4 o0 = (h0 + l0) + acc[ai][bj][m][0], o1 = (h1 + l1) + acc[ai][bj][m][1]; acc[ai][bj][m][0] = o0; acc[ai][bj][m][1] = o1; s += sumsq8(o0, o1); }
                s += __shfl_xor(s, 16); s += __shfl_xor(s, 32);
                if (fq == 0) atomicAdd(ss + row, s); }
            asm volatile("" ::: "memory");
        }
        asm volatile("s_waitcnt vmcnt(0)" ::: "memory");
        __syncthreads();
        if (wid == 0 && lane == 0) {
            __builtin_amdgcn_fence(__ATOMIC_RELEASE, "agent");
            unsigned* c = cnt + 64 * u.pm;
            __hip_atomic_fetch_add(c, 1u, __ATOMIC_RELAXED, __HIP_MEMORY_SCOPE_AGENT);
            unsigned spins = 0u;
            while (__hip_atomic_load(c, __ATOMIC_RELAXED, __HIP_MEMORY_SCOPE_AGENT) < 4u) { __builtin_amdgcn_s_sleep(2); if (++spins > (1u << 22)) break; }
            __builtin_amdgcn_fence(__ATOMIC_ACQUIRE, "agent");
        }
        __syncthreads();
        f32x4 gv[2][2];
#pragma unroll
        for (int bj = 0; bj < 2; ++bj)
#pragma unroll
            for (int n = 0; n < 2; ++n) gv[bj][n] = *(const f32x4*)(g + col0 + bj * HALF + n * 4);
        float ssv[2][4];
#pragma unroll
        for (int ai = 0; ai < 2; ++ai)
#pragma unroll
            for (int m = 0; m < 4; ++m) ssv[ai][m] = __hip_atomic_load(ss + u.pm * BM + ai * HALF + wr * 64 + m * 16 + fr, __ATOMIC_RELAXED, __HIP_MEMORY_SCOPE_AGENT);
#pragma unroll
        for (int ai = 0; ai < 2; ++ai)
#pragma unroll
            for (int m = 0; m < 4; ++m) { const int row = u.pm * BM + ai * HALF + wr * 64 + m * 16 + fr; const size_t off = (size_t)row * 1024 + col0; const float rstd = rsqrtf(ssv[ai][m] * (1.f / 1024.f) + RMS_EPS);
#pragma unroll
                for (int bj = 0; bj < 2; ++bj)
#pragma unroll
                    for (int n = 0; n < 2; ++n) *(f32x4*)(out + off + bj * HALF + n * 4) = acc[ai][bj][m][n] * rstd * gv[bj][n]; }
    }
};
struct EpiUp {
    static constexpr bool PERM = true, AFTER_DRAIN = false;
    bf16_t* H; const float* ss;
    __device__ __forceinline__ void operator()(const f32x4 (&acc)[2][2][4][2], const Unit& u, int wr, int wc, int fr, int fq) const {
        const int col0 = u.pn * BM + wc * 32 + 8 * fq;
        float rsv[2][4]; row_rstd(rsv, ss, u.pm * BM + wr * 64 + fr, 1.f / 1024.f, 1.f);
#pragma unroll
        for (int ai = 0; ai < 2; ++ai)
#pragma unroll
            for (int m = 0; m < 4; ++m) { const int row = u.pm * BM + ai * HALF + wr * 64 + m * 16 + fr; const float rs = rsv[ai][m];
                bf16_t* rowp = H + (size_t)row * 4096 + col0;
#pragma unroll
                for (int bj = 0; bj < 2; ++bj) { f32x4 a = acc[ai][bj][m][0] * rs, b = acc[ai][bj][m][1] * rs;
#pragma unroll
                    for (int j = 0; j < 4; ++j) { a[j] = fmaxf(a[j], 0.f); a[j] *= a[j]; b[j] = fmaxf(b[j], 0.f); b[j] *= b[j]; }
                    *(u32x4*)(rowp + bj * HALF) = pack8(a, b); } }
    }
};
struct EpiQKVA {
    static constexpr bool PERM = true, AFTER_DRAIN = false;
    bf16_t* CKV; bf16_t* QA; bf16_t* KR; const float* ss; float* ss_kv; float* ss_q; const float* rope;
    __device__ __forceinline__ void operator()(const f32x4 (&acc)[2][2][4][2], const Unit& u, int wr, int wc, int fr, int fq) const {
        const int cb = wc * 32 + 8 * fq;
        float rsv[2][4]; row_rstd(rsv, ss, u.pm * BM + wr * 64 + fr, 1.f / 1024.f, 1.f);
#pragma unroll
        for (int ai = 0; ai < 2; ++ai)
#pragma unroll
            for (int m = 0; m < 4; ++m) { const int row = u.pm * BM + ai * HALF + wr * 64 + m * 16 + fr; const float rs = rsv[ai][m];
                float s = 0.f;
#pragma unroll
                for (int bj = 0; bj < 2; ++bj) { f32x4 a = acc[ai][bj][m][0] * rs, b = acc[ai][bj][m][1] * rs;
                    if (u.pn == 0) { *(u32x4*)(CKV + (size_t)row * 256 + bj * HALF + cb) = pack8(a, b); s += sumsq8(a, b); }
                    else if (u.pn == 1) { *(u32x4*)(QA + (size_t)row * 384 + bj * HALF + cb) = pack8(a, b); s += sumsq8(a, b); }
                    else if (bj == 0) { *(u32x4*)(QA + (size_t)row * 384 + 256 + cb) = pack8(a, b); s += sumsq8(a, b); }
                    else if (wc < 2) { rope8(a, b, rope + ((size_t)(row & 8191) * 32 + (cb >> 1)) * 2); *(u32x4*)(KR + (size_t)row * 64 + cb) = pack8(a, b); } }
                s += __shfl_xor(s, 16); s += __shfl_xor(s, 32);
                if (fq == 0) atomicAdd((u.pn == 0 ? ss_kv : ss_q) + row, s); }
    }
};
struct EpiKVB {
    static constexpr bool PERM = true, AFTER_DRAIN = false;
    bf16_t* KV; const float* ss_kv;
    __device__ __forceinline__ void operator()(const f32x4 (&acc)[2][2][4][2], const Unit& u, int wr, int wc, int fr, int fq) const {
        const int col0 = u.pn * BM + wc * 32 + 8 * fq;
#pragma unroll
        for (int ai = 0; ai < 2; ++ai) { float rs4[4]; row_rstd4(rs4, ss_kv, u.pm * BM + ai * HALF + wr * 64 + fr, 1.f / 256.f, 1.f);
#pragma unroll
            for (int m = 0; m < 4; ++m) { const int row = u.pm * BM + ai * HALF + wr * 64 + m * 16 + fr; const float rs = rs4[m];
                bf16_t* rowp = KV + (size_t)row * 2048 + col0;
#pragma unroll
                for (int bj = 0; bj < 2; ++bj) *(u32x4*)(rowp + bj * HALF) = pack8(acc[ai][bj][m][0] * rs, acc[ai][bj][m][1] * rs); }
            asm volatile("" ::: "memory"); }
    }
};
struct EpiQB {
    static constexpr bool PERM = true, AFTER_DRAIN = false;
    bf16_t* Q; const float* ss_q; float qscale;
    __device__ __forceinline__ void operator()(const f32x4 (&acc)[2][2][4][2], const Unit& u, int wr, int wc, int fr, int fq) const {
        const int col0 = u.pn * BM + wc * 32 + 8 * fq;
#pragma unroll
        for (int ai = 0; ai < 2; ++ai) { float rs4[4]; row_rstd4(rs4, ss_q, u.pm * BM + ai * HALF + wr * 64 + fr, 1.f / 384.f, qscale);
#pragma unroll
            for (int m = 0; m < 4; ++m) { const int row = u.pm * BM + ai * HALF + wr * 64 + m * 16 + fr; const float rs = rs4[m];
                bf16_t* rowp = Q + (size_t)row * 1536 + col0;
#pragma unroll
                for (int bj = 0; bj < 2; ++bj) { f32x4 a = acc[ai][bj][m][0] * rs, b = acc[ai][bj][m][1] * rs;
                    *(u32x4*)(rowp + bj * HALF) = pack8(a, b); } }
            asm volatile("" ::: "memory"); }
    }
};
}
namespace att {
typedef unsigned short bf16_t;
typedef short bf16x8 __attribute__((ext_vector_type(8)));
typedef short s16x4 __attribute__((ext_vector_type(4)));
typedef float f32x16 __attribute__((ext_vector_type(16)));
typedef float f32x4 __attribute__((ext_vector_type(4)));
typedef unsigned u32x4 __attribute__((ext_vector_type(4)));
#define ASBAR() __builtin_amdgcn_sched_barrier(0)
constexpr double LOG2E_D = 1.4426950408889634;
__device__ __forceinline__ int v_st(int k, int c) { const int kk = (k & ~0xC) | ((k & 4) << 1) | ((k & 8) >> 1); return ((kk >> 3) * 4 + (c >> 5)) * 512 + ((kk & 7) * 32 + (c & 31)) * 2; }
__device__ __forceinline__ int v_rd_base(int lane) { return ((lane & 3) << 3) | (((lane >> 2) & 3) << 6) | (((lane >> 4) & 1) << 5) | (((lane >> 5) & 1) << 8); }
__device__ __forceinline__ int crow(int r, int hi) { return (r & 3) + 8 * (r >> 2) + 4 * hi; }
__device__ __forceinline__ float fadd_s(float a, float b) { float r; asm("v_add_f32_e32 %0, %1, %2" : "=v"(r) : "v"(a), "v"(b)); return r; }
__device__ __forceinline__ float fsub_s(float a, float b) { float r; asm("v_sub_f32_e32 %0, %1, %2" : "=v"(r) : "v"(a), "v"(b)); return r; }
__device__ __forceinline__ unsigned cvtpk(float lo, float hi) { unsigned r; asm volatile("v_cvt_pk_bf16_f32 %0, %1, %2" : "=v"(r) : "v"(lo), "v"(hi)); return r; }

struct Unit {
    const bf16_t* q[2]; int qs;
    const bf16_t* kA; int ksA;
    const bf16_t* kB; int ksB;
    const bf16_t* v; int vs;
    bf16_t* o; int os;
    const double* c;
    const unsigned* kmax2;
    const float* rtab;
    int q0, j_lo;
};
template <int DQK, int DV, bool BIAS> struct Lay {
    static constexpr int KROWB = DQK * 2, SHM_K = 64 * KROWB, SHM_V = 16384;
    static constexpr int OFF_K = 2 * SHM_V, OFF_WS = OFF_K + 2 * SHM_K, OFF_CK = OFF_WS + 2048, BYTES = OFF_CK + 32768;
};

template <int DQK, int DV, bool BIAS>
__device__ __forceinline__ void attn_unit(const Unit& U, char* lds) {
    typedef Lay<DQK, DV, BIAS> L;
    constexpr int NKB = DQK / 64, NVB = DV / 64, NQF = DQK / 16, NOD = DV / 32, KROWB = L::KROWB, SHM_K = L::SHM_K, SHM_V = L::SHM_V;
    int tid_ = threadIdx.x; asm volatile("" : "+v"(tid_));
    const int tid = tid_, wid = __builtin_amdgcn_readfirstlane(tid >> 6), lane = tid & 63, r32 = lane & 31, hi = lane >> 5;
    char* V_lds = lds; char* K_lds = lds + L::OFF_K;
    float* ws = (float*)(lds + L::OFF_WS) + wid * 64; float* li_l = ws; float* al_l = ws + 32;
    float* ckL = (float*)(lds + L::OFF_CK);
    const int q0 = U.q0;
    const int qlo = q0 + wid * 32, qrow = qlo + r32, qm = qrow - 4 * hi;
    const int vb0 = (int)(uintptr_t)V_lds + v_rd_base(lane);
    const unsigned lds0 = (unsigned)(uintptr_t)lds;
    const bf16_t* ksrc[NKB]; int kstep[NKB]; const bf16_t* vsrc[NVB];
#define A_SRCSETUP(KLO_) do { \
_Pragma("unroll") \
    for (int i = 0; i < NKB; ++i) { const int B_ = (wid * NKB + i) * 1024 + lane * 16, row = B_ / KROWB, ph = (B_ % KROWB) >> 4, lg = (ph & ~7) | ((ph & 7) ^ ((row >> 1) & 7)), col = lg * 8, blk = col >> 6; \
        const bool hiB = blk >= 2; const int st_ = hiB ? U.ksB : U.ksA; const size_t eo_ = (size_t)((KLO_) + row) * st_ + (hiB ? col - 128 : col); \
        ksrc[i] = (hiB ? U.kB : U.kA) + eo_; kstep[i] = 64 * st_; } \
_Pragma("unroll") \
    for (int i = 0; i < NVB; ++i) { const int B_ = (wid * NVB + i) * (DV == 64 ? 2048 : 1024) + lane * 16, st_ = B_ >> 9, e_ = (B_ & 511) >> 1, kk_ = (st_ >> 2) * 8 + (e_ >> 5); \
        const int k_ = (kk_ & ~0xC) | ((kk_ & 4) << 1) | ((kk_ & 8) >> 1), c_ = (st_ & 3) * 32 + (e_ & 31); \
        vsrc[i] = U.v + (size_t)((KLO_) + k_) * U.vs + c_; } \
    } while (0)
#define A_GLDS(gsrc, ldsdst) do { unsigned keep_; asm volatile("s_mov_b32 %0, m0\n\ts_mov_b32 m0, %2\n\ts_nop 0\n\tglobal_load_lds_dwordx4 %1, off\n\ts_mov_b32 m0, %0" : "=&s"(keep_) : "v"(gsrc), "s"(ldsdst) : "memory"); } while (0)
#define A_DMA(bf) do { \
        _Pragma("unroll") for (int i_ = 0; i_ < NKB; ++i_) { A_GLDS(ksrc[i_], (unsigned)__builtin_amdgcn_readfirstlane(lds0 + L::OFF_K + (bf) * SHM_K + (wid * NKB + i_) * 1024)); ksrc[i_] += kstep[i_]; } \
        _Pragma("unroll") for (int i_ = 0; i_ < NVB; ++i_) { A_GLDS(vsrc[i_], (unsigned)__builtin_amdgcn_readfirstlane(lds0 + (bf) * SHM_V + (wid * NVB + i_) * (DV == 64 ? 2048 : 1024))); vsrc[i_] += 64 * U.vs; } } while (0)
#define A_DMAWAIT() asm volatile("s_waitcnt vmcnt(0)" ::: "memory")
    double c0_ = 0.0, cqd_ = 0.0, csk_ = 0.0; unsigned k2a_ = 0u, k2b_ = 0u;
    if constexpr (BIAS) { c0_ = U.c[U.q0]; cqd_ = U.c[U.q0 + wid * 32 + r32]; if (tid < U.q0 / 64) csk_ = U.c[64 * tid + 63]; k2a_ = U.kmax2[0]; k2b_ = U.kmax2[1]; }
    else { A_SRCSETUP(U.j_lo * 64); A_DMA(0); }
    bf16x8 qr[NQF];
#pragma unroll
    for (int d0 = 0; d0 < NQF; ++d0) qr[d0] = *(const bf16x8*)(U.q[d0 >> 3] + (size_t)qrow * U.qs + (d0 & 7) * 16 + hi * 8);
    if constexpr (DQK == 192) {
#pragma unroll
        for (int d0 = 8; d0 < 12; ++d0) { const float* tab = U.rtab + ((size_t)qrow * 32 + 8 * (d0 - 8) + 4 * hi) * 2; const f32x4 t0 = *(const f32x4*)tab, t1 = *(const f32x4*)(tab + 4);
            const u32x4 w = *reinterpret_cast<const u32x4*>(&qr[d0]); u32x4 ov;
#pragma unroll
            for (int j = 0; j < 4; ++j) { const float a = __uint_as_float(w[j] << 16), b = __uint_as_float(w[j] & 0xffff0000u); const float c_ = j < 2 ? t0[2 * (j & 1)] : t1[2 * (j & 1)], s_ = j < 2 ? t0[2 * (j & 1) + 1] : t1[2 * (j & 1) + 1];
                ov[j] = cvtpk(a * c_ - b * s_, b * c_ + a * s_); }
            qr[d0] = *reinterpret_cast<const bf16x8*>(&ov); }
        char* qL_ = lds + L::OFF_CK + wid * 4096 + lane * 16;
#pragma unroll
        for (int d0 = 8; d0 < 12; ++d0) { *(bf16x8*)(qL_ + (d0 - 8) * 1024) = qr[d0]; }
        asm volatile("" ::: "memory"); }
    const char* qL = lds + L::OFF_CK + wid * 4096 + lane * 16;
    int j_lo = U.j_lo;
    if constexpr (BIAS) {
        float qn2 = 0.f;
#pragma unroll
        for (int d0 = 0; d0 < NQF; ++d0) { const u32x4 w = *reinterpret_cast<const u32x4*>(&qr[d0]);
#pragma unroll
            for (int j = 0; j < 4; ++j) { const float a = __uint_as_float(w[j] << 16), b = __uint_as_float(w[j] & 0xffff0000u); qn2 += a * a + b * b; } }
        { auto rr = __builtin_amdgcn_permlane32_swap(__float_as_uint(qn2), __float_as_uint(qn2), false, false); qn2 = __uint_as_float(rr[0]) + __uint_as_float(rr[1]); }
#pragma unroll
        for (int o_ = 1; o_ < 32; o_ <<= 1) qn2 = fmaxf(qn2, __shfl_xor(qn2, o_));
        float* wsb = (float*)(lds + L::OFF_WS);
        if (lane == 0) wsb[wid * 64] = qn2;
        __syncthreads();
        float qmax2 = wsb[0];
#pragma unroll
        for (int w = 1; w < 8; ++w) qmax2 = fmaxf(qmax2, wsb[w * 64]);
        const float k2 = __uint_as_float(k2a_) + __uint_as_float(k2b_);
        const float thr = 2.f * (sqrtf(qmax2 * k2) * 1.02f + 1e-3f) + 160.f;
        const int nprev = q0 / 64;
        bool sk = false; if (tid < nprev) sk = (float)((csk_ - c0_) * LOG2E_D) > thr;
        const unsigned long long bal = __ballot(sk);
        if (lane == 0) ((int*)wsb)[wid * 64 + 1] = __popcll(bal);
        __syncthreads();
        int cnt = 0;
#pragma unroll
        for (int w = 0; w < 8; ++w) cnt += ((int*)wsb)[w * 64 + 1];
        j_lo = cnt;
    }
    const int klo = j_lo * 64, NT = (q0 + 256) / 64 - j_lo;
    float cq = 0.f;
    if constexpr (BIAS) { A_SRCSETUP(klo); A_DMA(0);
        const double cref = c0_; cq = (float)((cqd_ - cref) * LOG2E_D);
        for (int s = klo + tid; s < q0 + 256; s += 512) ckL[s - klo] = (float)((U.c[s] - cref) * LOG2E_D); }
    A_DMAWAIT();
    __syncthreads();
    float mhat = 0.f, l_reg = 0.f; f32x16 o[NOD]; f32x16 negm; _Pragma("unroll") for (int r = 0; r < 16; ++r) negm[r] = cq; asm volatile("" : "+v"(negm));
#pragma unroll
    for (int d = 0; d < NOD; ++d) o[d] = f32x16{};
    const char* kbase = K_lds + r32 * KROWB;
    const int ksw = ((r32 >> 1) & 7) << 4;
#define A_TRRD(dst, off) asm volatile("ds_read_b64_tr_b16 %0, %1 offset:%2" : "=&v"(dst) : "v"(vb0), "i"(off) : "memory")
#define A_PV_RD(X, d0, BUF) do { constexpr int b_ = (BUF) * SHM_V + (d0) * 512; \
        A_TRRD(X##l0, b_); A_TRRD(X##h0, b_ + 2048); A_TRRD(X##l1, b_ + 4096); A_TRRD(X##h1, b_ + 6144); A_TRRD(X##l2, b_ + 8192); A_TRRD(X##h2, b_ + 10240); A_TRRD(X##l3, b_ + 12288); A_TRRD(X##h3, b_ + 14336); } while (0)
#define A_PV_MM(X, d0) do { \
        o[d0] = __builtin_amdgcn_mfma_f32_32x32x16_bf16(pa0, (bf16x8){X##l0[0], X##l0[1], X##l0[2], X##l0[3], X##h0[0], X##h0[1], X##h0[2], X##h0[3]}, o[d0], 0, 0, 0); \
        o[d0] = __builtin_amdgcn_mfma_f32_32x32x16_bf16(pa1, (bf16x8){X##l1[0], X##l1[1], X##l1[2], X##l1[3], X##h1[0], X##h1[1], X##h1[2], X##h1[3]}, o[d0], 0, 0, 0); \
        o[d0] = __builtin_amdgcn_mfma_f32_32x32x16_bf16(pa2, (bf16x8){X##l2[0], X##l2[1], X##l2[2], X##l2[3], X##h2[0], X##h2[1], X##h2[2], X##h2[3]}, o[d0], 0, 0, 0); \
        o[d0] = __builtin_amdgcn_mfma_f32_32x32x16_bf16(pa3, (bf16x8){X##l3[0], X##l3[1], X##l3[2], X##l3[3], X##h3[0], X##h3[1], X##h3[2], X##h3[3]}, o[d0], 0, 0, 0); } while (0)
#define A_LGKM(n) do { asm volatile("s_waitcnt lgkmcnt(" #n ")" ::: "memory"); ASBAR(); } while (0)
#define A_PV_ALL(BUF) do { s16x4 al0, al1, al2, al3, ah0, ah1, ah2, ah3, bl0, bl1, bl2, bl3, bh0, bh1, bh2, bh3; \
        A_PV_RD(a, 0, BUF); A_PV_RD(b, 1, BUF); A_LGKM(8); A_PV_MM(a, 0); ASBAR(); \
        if constexpr (NOD > 2) { A_PV_RD(a, 2 % NOD, BUF); A_LGKM(8); A_PV_MM(b, 1); ASBAR(); A_PV_RD(b, 3 % NOD, BUF); A_LGKM(8); A_PV_MM(a, 2 % NOD); ASBAR(); A_LGKM(0); A_PV_MM(b, 3 % NOD); } \
        else { A_LGKM(0); A_PV_MM(b, 1); } } while (0)
#define A_PK4(P, B_, OUT) do { unsigned a0 = cvtpk(P[B_ + 0], P[B_ + 1]), a1 = cvtpk(P[B_ + 2], P[B_ + 3]); unsigned b0 = cvtpk(P[B_ + 4], P[B_ + 5]), b1 = cvtpk(P[B_ + 6], P[B_ + 7]); \
        auto r0 = __builtin_amdgcn_permlane32_swap(a0, b0, false, false); auto r1 = __builtin_amdgcn_permlane32_swap(a1, b1, false, false); \
        u32x4 w = {r0[0], r1[0], r0[1], r1[1]}; OUT = *reinterpret_cast<bf16x8*>(&w); } while (0)
#define A_TILE(BUF, t, FIRST) do { \
        const int kb_ = klo + (t) * 64; const bool more_ = (t) + 1 < NT; \
        if (more_) A_DMA(1 - (BUF)); \
        ASBAR(); \
        f32x16 p0, p1; \
        _Pragma("unroll") for (int d0 = 0; d0 < NQF; ++d0) { const char* a_ = kbase + (BUF) * SHM_K + (d0 >> 2) * 128 + ((((d0 & 3) * 32) + hi * 16) ^ ksw); \
            const bf16x8 b0 = *(const bf16x8*)a_; const bf16x8 b1 = *(const bf16x8*)(a_ + 32 * KROWB); \
            const bf16x8 qf_ = d0 < 8 ? qr[d0 < 8 ? d0 : 0] : *(const bf16x8*)(qL + (d0 - 8) * 1024); \
            if (d0 == 0) { p0 = __builtin_amdgcn_mfma_f32_32x32x16_bf16(b0, qf_, negm, 0, 0, 0); p1 = __builtin_amdgcn_mfma_f32_32x32x16_bf16(b1, qf_, negm, 0, 0, 0); } \
            else { p0 = __builtin_amdgcn_mfma_f32_32x32x16_bf16(b0, qf_, p0, 0, 0, 0); p1 = __builtin_amdgcn_mfma_f32_32x32x16_bf16(b1, qf_, p1, 0, 0, 0); } if ((d0 & 1) == 1) ASBAR(); } \
        ASBAR(); \
        if constexpr (BIAS) { const float* ck_ = ckL + (kb_ - klo) + 4 * hi; \
            _Pragma("unroll") for (int g = 0; g < 4; ++g) { const f32x4 c0 = *(const f32x4*)(ck_ + 8 * g), c1 = *(const f32x4*)(ck_ + 32 + 8 * g); \
                _Pragma("unroll") for (int j = 0; j < 4; ++j) { p0[4 * g + j] = fsub_s(p0[4 * g + j], c0[j]); p1[4 * g + j] = fsub_s(p1[4 * g + j], c1[j]); } } } \
        if (kb_ + 63 > qlo) { const float NEG = -__builtin_inff(); const int dq = qm - kb_; \
            _Pragma("unroll") for (int r = 0; r < 16; ++r) { const int c = (r & 3) + 8 * (r >> 2); if (dq - c < 0) p0[r] = NEG; if (dq - c - 32 < 0) p1[r] = NEG; } } \
        float pmax = __builtin_fmaxf(__builtin_fmaxf(p0[0], p0[1]), p1[0]); float pmb = __builtin_fmaxf(__builtin_fmaxf(p0[2], p0[3]), p1[1]); pmax = __builtin_fmaxf(__builtin_fmaxf(pmax, p1[2]), p1[3]); \
        _Pragma("unroll") for (int r = 4; r < 16; r += 4) { pmax = __builtin_fmaxf(__builtin_fmaxf(pmax, p0[r]), p0[r + 1]); pmb = __builtin_fmaxf(__builtin_fmaxf(pmb, p0[r + 2]), p0[r + 3]); \
            pmax = __builtin_fmaxf(__builtin_fmaxf(pmax, p1[r]), p1[r + 1]); pmb = __builtin_fmaxf(__builtin_fmaxf(pmb, p1[r + 2]), p1[r + 3]); } \
        pmax = __builtin_fmaxf(pmax, pmb); \
        { auto rr = __builtin_amdgcn_permlane32_swap(__float_as_uint(pmax), __float_as_uint(pmax), false, false); pmax = fmaxf(__uint_as_float(rr[0]), __uint_as_float(rr[1])); } \
        if ((FIRST) || __any(pmax > 8.f)) { const float dl = (FIRST) ? pmax : fmaxf(pmax, 0.f); mhat += dl; \
            _Pragma("unroll") for (int r = 0; r < 16; ++r) { p0[r] -= dl; p1[r] -= dl; } \
            _Pragma("unroll") for (int r = 0; r < 16; ++r) negm[r] = cq - mhat; asm volatile("" : "+v"(negm)); \
            if (!(FIRST)) { const float alpha = __builtin_amdgcn_exp2f(-dl); l_reg *= alpha; if (hi == 0) al_l[r32] = alpha; asm volatile("s_waitcnt lgkmcnt(0)" ::: "memory"); \
                _Pragma("unroll") for (int d_ = 0; d_ < NOD; ++d_) _Pragma("unroll") for (int r = 0; r < 16; ++r) o[d_][r] *= al_l[crow(r, hi)]; } } \
        _Pragma("unroll") for (int r = 0; r < 16; ++r) { p0[r] = __builtin_amdgcn_exp2f(p0[r]); p1[r] = __builtin_amdgcn_exp2f(p1[r]); } \
        { float s0_ = fadd_s(p0[0], p1[0]), s1_ = fadd_s(p0[1], p1[1]), s2_ = fadd_s(p0[2], p1[2]), s3_ = fadd_s(p0[3], p1[3]); \
          _Pragma("unroll") for (int r = 4; r < 16; r += 4) { s0_ = fadd_s(s0_, p0[r]); s1_ = fadd_s(s1_, p0[r + 1]); s2_ = fadd_s(s2_, p0[r + 2]); s3_ = fadd_s(s3_, p0[r + 3]); \
              s0_ = fadd_s(s0_, p1[r]); s1_ = fadd_s(s1_, p1[r + 1]); s2_ = fadd_s(s2_, p1[r + 2]); s3_ = fadd_s(s3_, p1[r + 3]); } \
          const float ps = fadd_s(fadd_s(s0_, s1_), fadd_s(s2_, s3_)); \
          auto rr = __builtin_amdgcn_permlane32_swap(__float_as_uint(ps), __float_as_uint(ps), false, false); l_reg += __uint_as_float(rr[0]) + __uint_as_float(rr[1]); } \
        bf16x8 pa0, pa1, pa2, pa3; A_PK4(p0, 0, pa0); A_PK4(p0, 8, pa1); A_PK4(p1, 0, pa2); A_PK4(p1, 8, pa3); \
        ASBAR(); \
        A_PV_ALL(BUF); \
        A_DMAWAIT(); \
        __syncthreads(); } while (0)
    A_TILE(0, 0, true);
    int t = 1;
    for (; t + 1 < NT; t += 2) { A_TILE(1, t, false); A_TILE(0, t + 1, false); }
    if (t < NT) { A_TILE(1, t, false); }
    if (hi == 0) li_l[r32] = l_reg; asm volatile("s_waitcnt lgkmcnt(0)" ::: "memory");
    bf16_t* Ow = U.o + (size_t)qlo * U.os;
#pragma unroll
    for (int r = 0; r < 16; ++r) { const int orow = crow(r, hi); const float rl = __builtin_amdgcn_rcpf(li_l[orow]);
#pragma unroll
        for (int d0 = 0; d0 < NOD; ++d0) { const float v = o[d0][r] * rl; const float vn = __shfl_xor(v, 1);
            if ((r32 & 1) == 0) *(unsigned*)(Ow + (size_t)orow * U.os + d0 * 32 + r32) = cvtpk(v, vn); } }
    __syncthreads();
#undef A_GLDS
#undef A_SRCSETUP
#undef A_DMA
#undef A_DMAWAIT
#undef A_TRRD
#undef A_PV_RD
#undef A_PV_MM
#undef A_PV_ALL
#undef A_LGKM
#undef A_PK4
#undef A_TILE
}
}
#define LAS __attribute__((address_space(3)))
#define XB_TMO      128
#define XB_XCNT(j)  (256  + 64 * (j))
#define XB_XSUB(j)  (1280 + 64 * (j))
#define XB_XGEN(j)  (2304 + 64 * (j))
#define XB_TOP      3328
#define XB_TOPGEN   3392
#define XCD_BAR_WORDS 3456
#define XB_SPIN_CAP (1u << 18)

__device__ __forceinline__ unsigned xb_ld(unsigned* p)              { return __hip_atomic_load(p, __ATOMIC_RELAXED, __HIP_MEMORY_SCOPE_AGENT); }
__device__ __forceinline__ unsigned xb_add(unsigned* p, unsigned v) { return __hip_atomic_fetch_add(p, v, __ATOMIC_RELAXED, __HIP_MEMORY_SCOPE_AGENT); }
__device__ __forceinline__ unsigned xb_xcc_id() { return (unsigned)__builtin_amdgcn_s_getreg((3 << 11) | 20) & 0xFu; }
#define XB_SPIN(cond, bar) do { unsigned _sp = 0; while (cond) { __builtin_amdgcn_s_sleep(1); \
    if ((++_sp & 255u) == 0u) { if (xb_ld(&(bar)[XB_TMO])) break; if (_sp > XB_SPIN_CAP) { atomicAdd(&(bar)[XB_TMO], 1u); break; } } } } while (0)

struct XcdBarrier {
    unsigned* bar; unsigned x;
    volatile LAS unsigned* st;
};

__device__ __forceinline__ XcdBarrier xcd_barrier_post(unsigned* bar, volatile LAS unsigned* st) {
    XcdBarrier b; b.bar = bar; b.x = xb_xcc_id(); b.st = st;
    if (threadIdx.x == 0) (void)xb_add(&bar[XB_XCNT(b.x)], 1u);
    return b;
}
__device__ __forceinline__ void xcd_barrier_complete(unsigned* bar, unsigned x, unsigned& nloc, unsigned& nx) {
    const unsigned G = gridDim.x * gridDim.y * gridDim.z;
    unsigned sum, cnt, mine, sp = 0u;
    for (;;) {
        sum = 0u; cnt = 0u; mine = 0u;
#pragma unroll
        for (unsigned j = 0; j < 16; ++j) { const unsigned c = xb_ld(&bar[XB_XCNT(j)]); sum += c; cnt += (c > 0u) ? 1u : 0u; mine = (j == x) ? c : mine; }
        if (sum == G) break;
        __builtin_amdgcn_s_sleep(1);
        if ((++sp & 255u) == 0u) { if (xb_ld(&bar[XB_TMO])) break; if (sp > XB_SPIN_CAP) { atomicAdd(&bar[XB_TMO], 1u); break; } }
    }
    nloc = mine > 0u ? mine : 1u; nx = cnt > 0u ? cnt : 1u;
}

__device__ __forceinline__ void xcd_barrier(const XcdBarrier& b) {
    asm volatile("s_waitcnt vmcnt(0)" ::: "memory");
    __syncthreads();
    if (threadIdx.x == 0) {
        unsigned* bar = b.bar;
        __builtin_amdgcn_s_waitcnt(0);
        unsigned nloc = b.st[0], nx = b.st[1];
        if (nloc == 0u) { xcd_barrier_complete(bar, b.x, nloc, nx); b.st[0] = nloc; b.st[1] = nx; }
        const unsigned old = xb_add(&bar[XB_XSUB(b.x)], 1u);
        const unsigned gen = old / nloc;
        if (old + 1u == (gen + 1u) * nloc) {
            __builtin_amdgcn_fence(__ATOMIC_RELEASE, "agent");
            asm volatile("s_waitcnt vmcnt(0)" ::: "memory");
            const unsigned og = xb_add(&bar[XB_TOP], 1u);
            const unsigned tg = og / nx;
            if (og + 1u == (tg + 1u) * nx) xb_add(&bar[XB_TOPGEN], 1u);
            else XB_SPIN(xb_ld(&bar[XB_TOPGEN]) == tg, bar);
            __builtin_amdgcn_fence(__ATOMIC_ACQUIRE, "agent");
            xb_add(&bar[XB_XGEN(b.x)], 1u);
            asm volatile("s_waitcnt vmcnt(0)" ::: "memory");
        } else {
            XB_SPIN(xb_ld(&bar[XB_XGEN(b.x)]) == gen, bar);
            __builtin_amdgcn_fence(__ATOMIC_ACQUIRE, "agent");
            asm volatile("s_waitcnt vmcnt(0)" ::: "memory");
        }
    }
    __syncthreads();
}
typedef unsigned short bf16;
typedef unsigned v4u __attribute__((ext_vector_type(4)));
typedef float f32x4 __attribute__((ext_vector_type(4)));
constexpr int NWAVES = 8, M = 16384, SEQ = 8192, D = 1024, FF = 4096;
constexpr float RMS_EPS = 1e-6f;
constexpr float C2_FOX = 0.125f * 1.4426950408889634f;
constexpr float C2_MLA = 0.07216878364870323f * 1.4426950408889634f;
constexpr size_t MiB = 1u << 20;
constexpr size_t WS_CTL = 0, CTL_ZERO_BYTES = 1 * MiB;
constexpr size_t WS_ROPE = 1 * MiB, WS_LF = 3 * MiB, WS_C = 4 * MiB;
constexpr size_t WS_W = 8 * MiB;
constexpr size_t W_FIN = WS_W, W_FOUT = W_FIN + 6 * MiB, W_QKVA = W_FOUT + 2 * MiB, W_KVB = W_QKVA + 2 * MiB, W_QB = W_KVB + 1 * MiB, W_MOUT = W_QB + 2 * MiB,
                 W_UP0 = W_MOUT + 2 * MiB, W_UP1 = W_UP0 + 8 * MiB, W_DN0 = W_UP1 + 8 * MiB, W_DN1 = W_DN0 + 8 * MiB, W_END = W_DN1 + 8 * MiB;
constexpr size_t WS_XB = 56 * MiB;
constexpr size_t WS_H = 88 * MiB;
constexpr size_t WS_MKV = 88 * MiB, WS_MQ = 152 * MiB, WS_MKR = 248 * MiB  , WS_MO = 216 * MiB  , WS_CKV = 234 * MiB, WS_QA = 242 * MiB, WS_END = 254 * MiB;
static_assert(W_END <= WS_XB, "weights");
constexpr int SS_WORDS = 16384;
enum { SS0 = 1, SS1 = 2, SS2 = 3, SSKV = 4, SSQ = 5, SS3 = 6, SS4 = 7 };
constexpr int LDS_BYTES = 147456;

#define LDS_WAIT() asm volatile("s_waitcnt lgkmcnt(0)" ::: "memory")
__device__ __forceinline__ unsigned f2bf(float f) { unsigned u = __builtin_bit_cast(unsigned, f); return (u + 0x7fffu + ((u >> 16) & 1u)) >> 16; }
__device__ __forceinline__ unsigned pk2(float lo, float hi) { return f2bf(lo) | (f2bf(hi) << 16); }
__device__ __forceinline__ float wave_sum(float v) {
#pragma unroll
    for (int o = 1; o < 64; o <<= 1) v += __shfl_xor(v, o);
    return v;
}
__device__ __forceinline__ double wave_sum_d(double v) {
#pragma unroll
    for (int o = 1; o < 64; o <<= 1) { const int thi = __shfl_xor(__double2hiint(v), o), tlo = __shfl_xor(__double2loint(v), o); v += __hiloint2double(thi, tlo); }
    return v;
}
__device__ __forceinline__ void tr_item2(const float* W, int ldw, int srccol  , const float* g, int K, int k0, int n0, bf16* WT, LAS float* scr, int lane) {
    float t[32];
    const float* colp = W + (size_t)(k0 + (lane >> 5)) * ldw + (srccol < 0 ? 0 : srccol);
#pragma unroll
    for (int i = 0; i < 32; ++i) t[i] = colp[(size_t)(2 * i) * ldw];
    const float zf = srccol < 0 ? 0.f : 1.f;
#pragma unroll
    for (int i = 0; i < 32; ++i) scr[(2 * i + (lane >> 5)) * 33 + (lane & 31)] = t[i] * zf;
    const int c = lane & 7;
    f32x4 ga = {1.f, 1.f, 1.f, 1.f}, gb = {1.f, 1.f, 1.f, 1.f};
    if (g) { ga = *(const f32x4*)(g + k0 + 8 * c); gb = *(const f32x4*)(g + k0 + 8 * c + 4); }
    LDS_WAIT(); asm volatile("" ::: "memory");
#pragma unroll
    for (int j = 0; j < 4; ++j) { const int n = (lane >> 3) + 8 * j; const LAS float* sp = scr + (8 * c) * 33 + n;
        v4u o; o.x = pk2(sp[0 * 33] * ga.x, sp[1 * 33] * ga.y); o.y = pk2(sp[2 * 33] * ga.z, sp[3 * 33] * ga.w); o.z = pk2(sp[4 * 33] * gb.x, sp[5 * 33] * gb.y); o.w = pk2(sp[6 * 33] * gb.z, sp[7 * 33] * gb.w);
        *(v4u*)(WT + (size_t)(n0 + n) * K + k0 + 8 * c) = o; }
    LDS_WAIT(); asm volatile("" ::: "memory");
}

namespace pg8 {
struct FlexOrder : StaticOrder {
    int panel, ppm, member;
    const unsigned* wait_word;
    __device__ __forceinline__ bool next(int i, Unit& u) const {
        if (panel) { const int pn = member + 4 * i; if (pn >= nN) return false; u.pm = ppm; u.pn = pn; return true; }
        return StaticOrder::next(i, u);
    }
    __device__ __forceinline__ void a_ready(const Unit& u) const {
        if (wait_word && u.pn == member) {
            if (threadIdx.x == 0) { unsigned sp = 0u;
                while (__hip_atomic_load(wait_word, __ATOMIC_RELAXED, __HIP_MEMORY_SCOPE_AGENT) < 4u) { __builtin_amdgcn_s_sleep(1); if (++sp > (1u << 22)) break; }
                __builtin_amdgcn_fence(__ATOMIC_ACQUIRE, "agent");
                asm volatile("s_waitcnt vmcnt(0)" ::: "memory"); }
            asm volatile("" ::: "memory"); __builtin_amdgcn_s_barrier(); asm volatile("" ::: "memory");
        }
    }
};
}
__device__ __forceinline__ void group_barrier(unsigned* cnt, bool same_l2) {
    asm volatile("s_waitcnt vmcnt(0)" ::: "memory");
    __syncthreads();
    if (threadIdx.x == 0) {
        if (!same_l2) __builtin_amdgcn_fence(__ATOMIC_RELEASE, "agent");
        asm volatile("s_waitcnt vmcnt(0)" ::: "memory");
        __hip_atomic_fetch_add(cnt, 1u, __ATOMIC_RELAXED, __HIP_MEMORY_SCOPE_AGENT);
        unsigned sp = 0u;
        while (__hip_atomic_load(cnt, __ATOMIC_RELAXED, __HIP_MEMORY_SCOPE_AGENT) < 4u) { __builtin_amdgcn_s_sleep(1); if (++sp > (1u << 22)) break; }
        __builtin_amdgcn_fence(__ATOMIC_ACQUIRE, "agent");
        asm volatile("s_waitcnt vmcnt(0)" ::: "memory");
    }
    __syncthreads();
}
__device__ __forceinline__ void group_arrive(unsigned* cnt, bool same_l2) {
    asm volatile("s_waitcnt vmcnt(0)" ::: "memory");
    __syncthreads();
    if (threadIdx.x == 0) {
        if (!same_l2) __builtin_amdgcn_fence(__ATOMIC_RELEASE, "agent");
        asm volatile("s_waitcnt vmcnt(0)" ::: "memory");
        __hip_atomic_fetch_add(cnt, 1u, __ATOMIC_RELAXED, __HIP_MEMORY_SCOPE_AGENT);
    }
}
#ifndef PROBE_PH
#define PROBE_PH -1
#endif
struct Args { const float* in[17]; float* out; unsigned char* ws; int ph_lo, ph_hi; };

__global__ void __launch_bounds__(NWAVES * 64, 2) yoco_fwd(Args args) {
    extern __shared__ __attribute__((aligned(16))) unsigned char lds[];
    cg::grid_group grid = cg::this_grid();
#define TID_INIT() int tid_ = threadIdx.x; asm volatile("" : "+v"(tid_)); const int tid = tid_, lane = tid & 63, wave = __builtin_amdgcn_readfirstlane(tid >> 6); const int gw = vcu * NWAVES + wave; (void)lane; (void)gw
    const int G = gridDim.x, bx = blockIdx.x;
    for (int u_ = threadIdx.x; u_ < (LDS_BYTES - 131072) / 4; u_ += NWAVES * 64) ((LAS unsigned*)(lds + 131072))[u_] = 0u;
    __syncthreads();
    const XcdBarrier xbar = xcd_barrier_post((unsigned*)(args.ws + WS_CTL) + 4096, (volatile LAS unsigned*)(lds + 131072 + 320) + 8);
    const bool panel_mode = (G == 256);
    const int g_pm = 8 * (bx & 7) + ((bx >> 3) & 7), g_mem = bx >> 6;
    unsigned* const gctl = (unsigned*)(args.ws + WS_CTL + 576 * 1024);
    if (panel_mode && threadIdx.x == 0) __hip_atomic_store(gctl + bx, xb_xcc_id() + 1u, __ATOMIC_RELAXED, __HIP_MEMORY_SCOPE_AGENT);
    bool same_l2 = false;
    const int vcu = (G % 8 == 0) ? (bx % 8) * (G / 8) + bx / 8 : bx;
#define ws (args.ws)
#define x_in (args.in[0])
#define g_mix (args.in[1])
#define g_ffn (args.in[2])
#define w_fin (args.in[3])
#define b_f (args.in[4])
#define w_fout (args.in[5])
#define g_kv (args.in[6])
#define w_kva (args.in[7])
#define g_kva (args.in[8])
#define w_kvb (args.in[9])
#define w_qa (args.in[10])
#define g_qa (args.in[11])
#define w_qb (args.in[12])
#define w_mout (args.in[13])
#define w_up (args.in[14])
#define w_dn (args.in[15])
#define g_fin (args.in[16])
#define out (args.out)
#define ssb ((float*)(ws + WS_CTL))
#define SS(i) (ssb + (size_t)(i) * SS_WORDS)
#define rope ((float*)(ws + WS_ROPE))
#define lf ((float*)(ws + WS_LF))
#define cc ((double*)(ws + WS_C))
#define XB ((bf16*)(ws + WS_XB))
#define FQB ((bf16*)out)
#define FKB ((bf16*)out + (size_t)M * 1024)
#define FVB ((bf16*)(ws + WS_MO))
#define CKVB ((bf16*)out)
#define QAB ((bf16*)out + (size_t)M * 256)
#ifndef STREAM_LO
#define STREAM_LO 0
#endif
#define LOB (STREAM_LO ? (bf16*)out : (bf16*)nullptr)
#define HB ((bf16*)(ws + WS_H))
    const int lo = args.ph_lo, hi_ph = args.ph_hi;
#ifndef PHMASK
#define PHMASK 0xffffffffu
#endif
#define IN(k) (((PHMASK >> (k)) & 1u) && lo <= (k) && (k) < hi_ph)
#define SEAM(k) do { if (IN(k) && IN((k) + 1)) { if (args.ph_lo < 0) grid.sync();   xcd_barrier(xbar); } } while (0)
    const int NGW = G * NWAVES;
#define GSEAM(k) do { if (IN(k) && IN((k) + 1)) { if (panel_mode) group_barrier(gctl + 1024 + ((k) * 64 + g_pm) * 16, same_l2); else xcd_barrier(xbar); } } while (0)
#define FLEX(S, N_) pg8::FlexOrder S; S.init(M, (N_), G, bx); S.panel = panel_mode ? 1 : 0; S.ppm = g_pm; S.member = g_mem; S.wait_word = nullptr
#define GARRIVE(k) do { if (IN(k) && IN((k) + 1)) { if (panel_mode) group_arrive(gctl + 1024 + ((k) * 64 + g_pm) * 16, same_l2); else xcd_barrier(xbar); } } while (0)
#define FLEXW(S, N_, k) FLEX(S, N_); S.wait_word = (panel_mode && IN(k) && IN((k) + 1)) ? gctl + 1024 + ((k) * 64 + g_pm) * 16 : nullptr

    if (IN(0)) for (int rep_ = 0; rep_ < (PROBE_PH == 0 ? 2 : 1); ++rep_) { TID_INIT();
        LAS float* gwl = (LAS float*)lds;
        for (int i = tid; i < 4 * 1024; i += NWAVES * 64) { const int k = i >> 2, h4 = (i & 3) * 4; const f32x4 w4 = *(const f32x4*)(w_fin + (size_t)k * 3088 + 3072 + h4); const float gk = g_mix[k];
            gwl[(h4 + 0) * 1024 + k] = w4.x * gk; gwl[(h4 + 1) * 1024 + k] = w4.y * gk; gwl[(h4 + 2) * 1024 + k] = w4.z * gk; gwl[(h4 + 3) * 1024 + k] = w4.w * gk; }
        __syncthreads();
        {
            f32x4 v[4], vn[4];
            const int NRW = NGW;
            int m = gw;
            if (m < M) { const f32x4* xr = (const f32x4*)(x_in + (size_t)m * D) + lane;
#pragma unroll
                for (int j = 0; j < 4; ++j) v[j] = xr[64 * j]; }
            for (; m < M; m += NRW) {
                const int mn = m + NRW;
                if (mn < M) { const f32x4* xr = (const f32x4*)(x_in + (size_t)mn * D) + lane;
#pragma unroll
                    for (int j = 0; j < 4; ++j) vn[j] = xr[64 * j]; }
                float s = 0.f;
#pragma unroll
                for (int j = 0; j < 4; ++j) s += (v[j].x * v[j].x + v[j].y * v[j].y) + (v[j].z * v[j].z + v[j].w * v[j].w);
                s = wave_sum(s);
                if (lane == 0) SS(SS0)[m] = s;
                unsigned long long* o8 = (unsigned long long*)(XB + (size_t)m * D) + lane;
#pragma unroll
                for (int j = 0; j < 4; ++j) o8[64 * j] = (unsigned long long)pk2(v[j].x, v[j].y) | ((unsigned long long)pk2(v[j].z, v[j].w) << 32);
                const float rstd = rsqrtf(s * (1.f / D) + RMS_EPS);
                float acc[16];
#pragma unroll
                for (int h = 0; h < 16; ++h) { float d = 0.f;
#pragma unroll
                    for (int j = 0; j < 4; ++j) { const f32x4 w = *(const LAS f32x4*)(gwl + h * 1024 + 256 * j + 4 * lane); d += (v[j].x * w.x + v[j].y * w.y) + (v[j].z * w.z + v[j].w * w.w); }
                    acc[h] = d; if ((h & 3) == 3) asm volatile("" ::: "memory"); }
#pragma unroll
                for (int i = 0; i < 8; ++i) { const bool up = (lane & 32) != 0; const float keep = up ? acc[i + 8] : acc[i], send = up ? acc[i] : acc[i + 8]; acc[i] = keep + __shfl_xor(send, 32); }
#pragma unroll
                for (int i = 0; i < 4; ++i) { const bool up = (lane & 16) != 0; const float keep = up ? acc[i + 4] : acc[i], send = up ? acc[i] : acc[i + 4]; acc[i] = keep + __shfl_xor(send, 16); }
#pragma unroll
                for (int i = 0; i < 2; ++i) { const bool up = (lane & 8) != 0; const float keep = up ? acc[i + 2] : acc[i], send = up ? acc[i] : acc[i + 2]; acc[i] = keep + __shfl_xor(send, 8); }
                { const bool up = (lane & 4) != 0; const float keep = up ? acc[1] : acc[0], send = up ? acc[0] : acc[1]; acc[0] = keep + __shfl_xor(send, 4); }
                acc[0] += __shfl_xor(acc[0], 2); acc[0] += __shfl_xor(acc[0], 1);
                if ((lane & 3) == 0) { const int h = ((lane >> 5) & 1) * 8 + ((lane >> 4) & 1) * 4 + ((lane >> 3) & 1) * 2 + ((lane >> 2) & 1);
                    const float z = acc[0] * rstd + b_f[h]; const float ls = fminf(z, 0.f) - log1pf(expf(-fabsf(z)));
                    lf[(size_t)((m >> 13) * 16 + h) * SEQ + (m & (SEQ - 1))] = ls; }
#pragma unroll
                for (int j = 0; j < 4; ++j) v[j] = vn[j];
            }
        }
        for (int idx = bx * (NWAVES * 64) + tid; idx < SEQ * 32; idx += G * NWAVES * 64) { const int pos = idx >> 5, i = idx & 31;
            const float inv = exp2f(-(float)i * (13.287712379549449f / 32.f)); const float ang = (float)pos * inv;
            double rv = (double)ang * 0.15915494309189535; rv -= __builtin_rint(rv); const float fr = (float)rv;
            rope[2 * idx] = __builtin_amdgcn_cosf(fr); rope[2 * idx + 1] = __builtin_amdgcn_sinf(fr); }
        __syncthreads();
        LAS float* scr = (LAS float*)(lds + wave * 16384);
        constexpr int I0 = 16 * 96, I1 = 16 * 32, I2 = 16 * 24, I3 = 4 * 64, I4 = 6 * 48, I5 = 16 * 32, I6 = 16 * 128, I8 = 64 * 32;
        constexpr int NIT = I0 + I1 + I2 + I3 + I4 + I5 + 2 * I6 + 2 * I8;
        for (int it = gw; it < NIT; it += NGW) { int r = it; const int nl = lane & 31;
#define TR_PLAIN(Wp, ldw_, gp, K_, nblk_, dst_) do { const int k0_ = 64 * (r / (nblk_)), n0_ = 32 * (r % (nblk_)); tr_item2((Wp), (ldw_), n0_ + nl, (gp), (K_), k0_, n0_, (bf16*)(ws + (dst_)), scr, lane); } while (0)
            if (r < I0) { TR_PLAIN(w_fin, 3088, g_mix, 1024, 96, W_FIN); continue; } r -= I0;
            if (r < I1) { TR_PLAIN(w_fout, 1024, nullptr, 1024, 32, W_FOUT); continue; } r -= I1;
            if (r < I2) { const int k0_ = 64 * (r / 24), n0_ = 32 * (r % 24), n_ = n0_ + nl;
                if (n0_ < 256) tr_item2(w_kva, 320, n_, g_kv, 1024, k0_, n0_, (bf16*)(ws + W_QKVA), scr, lane);
                else if (n0_ < 640) tr_item2(w_qa, 384, n_ - 256, g_mix + D, 1024, k0_, n0_, (bf16*)(ws + W_QKVA), scr, lane);
                else if (n0_ < 704) { const int c2 = n_ - 640; tr_item2(w_kva, 320, 256 + (c2 >> 1) + 32 * (c2 & 1), g_kv, 1024, k0_, n0_, (bf16*)(ws + W_QKVA), scr, lane); }
                else tr_item2(w_kva, 320, -1, nullptr, 1024, k0_, n0_, (bf16*)(ws + W_QKVA), scr, lane);
                continue; } r -= I2;
            if (r < I3) { TR_PLAIN(w_kvb, 2048, g_kva, 256, 64, W_KVB); continue; } r -= I3;
            if (r < I4) { const int k0_ = 64 * (r / 48), n0_ = 32 * (r % 48), n_ = n0_ + nl; int src;
                if (n_ < 1024) src = (n_ >> 7) * 192 + (n_ & 127); else { const int q_ = n_ - 1024; src = (q_ >> 6) * 192 + 128 + ((q_ & 63) >> 1) + 32 * (q_ & 1); }
                tr_item2(w_qb, 1536, src, g_qa, 384, k0_, n0_, (bf16*)(ws + W_QB), scr, lane); continue; } r -= I4;
            if (r < I5) { if (!panel_mode) TR_PLAIN(w_mout, 1024, nullptr, 1024, 32, W_MOUT); continue; } r -= I5;
            if (r < I6) { TR_PLAIN(w_up, 4096, g_ffn, 1024, 128, W_UP0); continue; } r -= I6;
            if (r < I6) { if (!panel_mode) TR_PLAIN(w_up + (size_t)D * FF, 4096, g_ffn + D, 1024, 128, W_UP1); continue; } r -= I6;
            if (r < I8) { TR_PLAIN(w_dn, 1024, nullptr, 4096, 32, W_DN0); continue; } r -= I8;
            if (!panel_mode) TR_PLAIN(w_dn + (size_t)FF * D, 1024, nullptr, 4096, 32, W_DN1);
        }
        __syncthreads();
    }
    SEAM(0);
    if (IN(1)) for (int rep_ = 0; rep_ < (PROBE_PH == 1 ? 2 : 1); ++rep_) { TID_INIT();
        LAS double* red = (LAS double*)lds;
        for (int w = bx; w < 256; w += G) { const int bh = w >> 3, ch = w & 7; const float* src = lf + (size_t)bh * SEQ;
            double p = 0.0; { float pv_[14];
#pragma unroll
                for (int k = 0; k < 14; ++k) { const int i = tid + k * (NWAVES * 64); pv_[k] = i < ch * 1024 ? src[i] : 0.f; }
#pragma unroll
                for (int k = 0; k < 14; ++k) p += (double)pv_[k]; }
            p = wave_sum_d(p); if (lane == 0) red[wave] = p;
            __syncthreads();
            double pre = 0.0;
#pragma unroll
            for (int k = 0; k < 8; ++k) pre += red[k];
            const float a = src[ch * 1024 + 2 * tid], b = src[ch * 1024 + 2 * tid + 1]; const double s2 = (double)a + (double)b;
            double inc = s2;
#pragma unroll
            for (int o = 1; o < 64; o <<= 1) { const int thi = __shfl_up(__double2hiint(inc), o), tlo = __shfl_up(__double2loint(inc), o); if (lane >= o) inc += __hiloint2double(thi, tlo); }
            if (lane == 63) red[8 + wave] = inc;
            __syncthreads();
            double woff = 0.0;
#pragma unroll
            for (int k = 0; k < 8; ++k) if (k < wave) woff += red[8 + k];
            const double excl = pre + woff + inc - s2;
            cc[(size_t)bh * SEQ + ch * 1024 + 2 * tid] = excl + (double)a; cc[(size_t)bh * SEQ + ch * 1024 + 2 * tid + 1] = excl + s2;
            __syncthreads();
        }
        pg8::Gemm g{XB, (const bf16*)(ws + W_FIN), M, 3072, 1024}; pg8::StaticOrder S; S.init(M, 3072, G, bx);
        pg8::EpiQKV E{FQB, (size_t)M * 1024, FVB, SS(SS0), C2_FOX, (unsigned*)(ws + WS_CTL + 512 * 1024)};
        pg8::gemm_phase<pg8::EpiQKV, pg8::StaticOrder, true, true>((LAS unsigned char*)lds, g, S, E);
    }
    SEAM(1);
    if (panel_mode) {
        if (threadIdx.x == 0) { const unsigned mine = __hip_atomic_load(gctl + bx, __ATOMIC_RELAXED, __HIP_MEMORY_SCOPE_AGENT); unsigned same = 1u;
#pragma unroll
            for (int m_ = 0; m_ < 4; ++m_) same &= (__hip_atomic_load(gctl + 8 * ((g_pm & 7) + 8 * m_) + (g_pm >> 3), __ATOMIC_RELAXED, __HIP_MEMORY_SCOPE_AGENT) == mine) ? 1u : 0u;
            ((LAS unsigned*)(lds + 131072))[16] = same; }
        __syncthreads();
        same_l2 = ((LAS unsigned*)(lds + 131072))[16] != 0u;
    }
    if (IN(2)) {
        for (int i = 0, idx = vcu; panel_mode ? i < 4 : idx < 1024; ++i, idx += G) { int bh, qb;
            if (panel_mode) { bh = (g_pm >> 5) * 16 + 4 * g_mem + i; qb = g_pm & 31; }
            else { const int k4 = idx >> 8, v = idx & 255, s_ = v & 7; bh = v >> 3; qb = (k4 == 0) ? s_ : (k4 == 1) ? 15 - s_ : (k4 == 2) ? 16 + s_ : 31 - s_; }
            const int b = bh >> 4, h = bh & 15;
            att::Unit U; const size_t ro = (size_t)b * SEQ * 1024 + h * 64;
            U.q[0] = FQB + ro; U.q[1] = U.q[0]; U.qs = 1024;
            U.kA = FKB + ro; U.ksA = 1024; U.kB = U.kA; U.ksB = 1024;
            U.v = FVB + ro; U.vs = 1024;
            U.o = FQB + ro; U.os = 1024; U.c = cc + (size_t)bh * SEQ; U.rtab = nullptr; U.kmax2 = (const unsigned*)(ws + WS_CTL + 512 * 1024) + bh * 2; U.q0 = qb * 256; U.j_lo = 0;
            att::attn_unit<64, 64, true>(U, (char*)lds);
        }
    }
    GARRIVE(2);
    if (IN(3)) {
        pg8::Gemm g{FQB, (const bf16*)(ws + W_FOUT), M, 1024, 1024}; FLEXW(S, 1024, 2);
        pg8::EpiRes E{STREAM_LO ? x_in : (const float*)nullptr, XB, LOB, SS(SS1)};
        pg8::gemm_phase<pg8::EpiRes, pg8::FlexOrder, true, true>((LAS unsigned char*)lds, g, S, E);
    }
    GARRIVE(3);
    if (IN(4)) for (int rep_ = 0; rep_ < (PROBE_PH == 4 ? 2 : 1); ++rep_) {
        pg8::Gemm g{XB, (const bf16*)(ws + W_UP0), M, 4096, 1024}; FLEXW(S, 4096, 3);
        pg8::EpiUp E{HB, SS(SS1)};
        pg8::gemm_phase<pg8::EpiUp, pg8::FlexOrder, true, true>((LAS unsigned char*)lds, g, S, E);
    }
    GARRIVE(4);
    if (IN(5)) {
        pg8::Gemm g{HB, (const bf16*)(ws + W_DN0), M, 1024, 4096}; FLEXW(S, 1024, 4);
        pg8::EpiRes E{nullptr, XB, LOB, SS(SS2)};
        pg8::gemm_phase<pg8::EpiRes, pg8::FlexOrder, true, true>((LAS unsigned char*)lds, g, S, E);
    }
    GSEAM(5);
    if (IN(6) && panel_mode) {
        if (threadIdx.x == 0) { const int dep[3] = {g_pm >> 2, (4096 + 96 * g_pm) >> 8, (4096 + 96 * g_pm + 95) >> 8};
#pragma unroll
            for (int d_ = 0; d_ < 3; ++d_) { const unsigned* c_ = gctl + 1024 + (3 * 64 + dep[d_]) * 16; unsigned sp = 0u;
                while (__hip_atomic_load(c_, __ATOMIC_RELAXED, __HIP_MEMORY_SCOPE_AGENT) < 4u) { __builtin_amdgcn_s_sleep(1); if (++sp > (1u << 22)) break; } } }
        __syncthreads();
    }
    if (IN(6)) {
        if (panel_mode && g_mem == 3) { TID_INIT();
            LAS float* scr = (LAS float*)(lds + wave * 16384); const int nl = lane & 31;
            for (int it = g_pm * NWAVES + wave; it < 512 + 2048 + 2048; it += 64 * NWAVES) { int r = it;
                if (r < 512) { TR_PLAIN(w_mout, 1024, nullptr, 1024, 32, W_MOUT); continue; } r -= 512;
                if (r < 2048) { TR_PLAIN(w_up + (size_t)D * FF, 4096, g_ffn + D, 1024, 128, W_UP1); continue; } r -= 2048;
                TR_PLAIN(w_dn + (size_t)FF * D, 1024, nullptr, 4096, 32, W_DN1); }
            __syncthreads();
        }
        pg8::Gemm g{XB, (const bf16*)(ws + W_QKVA), M, 768, 1024}; FLEX(S, 768);
        pg8::EpiQKVA E{CKVB, QAB, (bf16*)(ws + WS_MKR), SS(SS2), SS(SSKV), SS(SSQ), rope};
        pg8::gemm_phase<pg8::EpiQKVA, pg8::FlexOrder, true, true>((LAS unsigned char*)lds, g, S, E);
    }
    GSEAM(6);
    if (IN(7) && panel_mode) {
        if (threadIdx.x == 0) { const int dep[3] = {g_pm >> 1, (256 + 3 * g_pm) >> 3, (258 + 3 * g_pm) >> 3};
#pragma unroll
            for (int d_ = 0; d_ < 3; ++d_) { const unsigned* c_ = gctl + 1024 + (5 * 64 + dep[d_]) * 16; unsigned sp = 0u;
                while (__hip_atomic_load(c_, __ATOMIC_RELAXED, __HIP_MEMORY_SCOPE_AGENT) < 4u) { __builtin_amdgcn_s_sleep(1); if (++sp > (1u << 22)) break; } } }
        __syncthreads();
    }
    if (IN(7)) for (int rep_ = 0; rep_ < (PROBE_PH == 7 ? 2 : 1); ++rep_) {
        { pg8::Gemm g{CKVB, (const bf16*)(ws + W_KVB), M, 2048, 256}; FLEX(S, 2048);
          pg8::EpiKVB E{(bf16*)(ws + WS_MKV), SS(SSKV)};
          pg8::gemm_phase<pg8::EpiKVB, pg8::FlexOrder, true, true>((LAS unsigned char*)lds, g, S, E); }
        { pg8::Gemm g{QAB, (const bf16*)(ws + W_QB), M, 1536, 384}; FLEX(S, 1536);
          pg8::EpiQB E{(bf16*)(ws + WS_MQ), SS(SSQ), C2_MLA};
          pg8::gemm_phase<pg8::EpiQB, pg8::FlexOrder, false, true>((LAS unsigned char*)lds, g, S, E); }
    }
    SEAM(7);
    if (IN(8)) for (int rep_ = 0; rep_ < (PROBE_PH == 8 ? 2 : 1); ++rep_) {
        for (int i = vcu; i < 512; i += G) { const int k2 = i >> 8, v = i & 255, bh = v >> 4, s = v & 15, b = bh >> 3, h = bh & 7;
            const int qb = (k2 == 0) ? 31 - s : s;
            att::Unit U; const size_t rq = (size_t)b * SEQ * 1536, rk = (size_t)b * SEQ * 2048;
            U.q[0] = (const bf16*)(ws + WS_MQ) + rq + h * 128; U.q[1] = (const bf16*)(ws + WS_MQ) + rq + 1024 + h * 64; U.qs = 1536;
            U.kA = (const bf16*)(ws + WS_MKV) + rk + h * 256; U.ksA = 2048; U.kB = (const bf16*)(ws + WS_MKR) + (size_t)b * SEQ * 64; U.ksB = 64;
            U.v = (const bf16*)(ws + WS_MKV) + rk + h * 256 + 128; U.vs = 2048;
            U.o = (bf16*)(ws + WS_MO) + (size_t)b * SEQ * 1024 + h * 128; U.os = 1024; U.c = nullptr; U.kmax2 = nullptr; U.rtab = rope; U.q0 = qb * 256; U.j_lo = 0;
            att::attn_unit<192, 128, false>(U, (char*)lds);
        }
    }
    SEAM(8);
    if (IN(9)) {
        pg8::Gemm g{(const bf16*)(ws + WS_MO), (const bf16*)(ws + W_MOUT), M, 1024, 1024}; FLEX(S, 1024);
        pg8::EpiRes E{nullptr, XB, LOB, SS(SS3)};
        pg8::gemm_phase<pg8::EpiRes, pg8::FlexOrder, true, true>((LAS unsigned char*)lds, g, S, E);
    }
    GARRIVE(9);
    if (IN(10)) {
        pg8::Gemm g{XB, (const bf16*)(ws + W_UP1), M, 4096, 1024}; FLEXW(S, 4096, 9);
        pg8::EpiUp E{HB, SS(SS3)};
        pg8::gemm_phase<pg8::EpiUp, pg8::FlexOrder, true, true>((LAS unsigned char*)lds, g, S, E);
    }
    GARRIVE(10);
    if (IN(11)) {
        pg8::Gemm g{HB, (const bf16*)(ws + W_DN1), M, 1024, 4096}; FLEXW(S, 1024, 10);
        if (G == 256) {
            pg8::EpiResFinal E{XB, LOB, out, SS(SS4), g_fin, (unsigned*)(ws + WS_CTL + 40960)};
            pg8::gemm_phase<pg8::EpiResFinal, pg8::FlexOrder, false, true>((LAS unsigned char*)lds, g, S, E);
        } else {
            pg8::EpiRes E{nullptr, XB, LOB, SS(SS4)};
            pg8::gemm_phase<pg8::EpiRes, pg8::FlexOrder, true, true>((LAS unsigned char*)lds, g, S, E);
            xcd_barrier(xbar);
            TID_INIT();
            if (wave == 0) for (int pm_ = bx; pm_ < M / 256; pm_ += G) for (int rr = 255; rr >= 0; --rr) { const int m = pm_ * 256 + rr;
                const float rstd = rsqrtf(SS(SS4)[m] * (1.f / D) + RMS_EPS); f32x4 v[4];
#pragma unroll
                for (int j = 0; j < 4; ++j) { const size_t e = (size_t)m * D + 256 * j + 4 * lane; const unsigned long long hw = *(const unsigned long long*)(XB + e), lw = STREAM_LO ? *(const unsigned long long*)((const bf16*)out + (size_t)pm_ * 262144 + e) : 0ull;
                    v[j].x = __uint_as_float((unsigned)hw << 16) + __uint_as_float((unsigned)lw << 16); v[j].y = __uint_as_float((unsigned)hw & 0xffff0000u) + __uint_as_float((unsigned)lw & 0xffff0000u);
                    v[j].z = __uint_as_float((unsigned)(hw >> 32) << 16) + __uint_as_float((unsigned)(lw >> 32) << 16); v[j].w = __uint_as_float((unsigned)(hw >> 32) & 0xffff0000u) + __uint_as_float((unsigned)(lw >> 32) & 0xffff0000u); }
                asm volatile("s_waitcnt vmcnt(0)" ::: "memory");
#pragma unroll
                for (int j = 0; j < 4; ++j) *((f32x4*)(out + (size_t)m * D) + 64 * j + lane) = v[j] * rstd * *((const f32x4*)g_fin + 64 * j + lane);
                asm volatile("s_waitcnt vmcnt(0)" ::: "memory"); }
        }
    }
#undef TR_PLAIN
#undef IN
#undef SEAM
#undef GSEAM
#undef FLEX
#undef FLEXW
#undef GARRIVE
#undef SS
#undef x_in
#undef g_mix
#undef g_ffn
#undef w_fin
#undef b_f
#undef w_fout
#undef g_kv
#undef w_kva
#undef g_kva
#undef w_kvb
#undef w_qa
#undef g_qa
#undef w_qb
#undef w_mout
#undef w_up
#undef w_dn
#undef g_fin
#undef out
#undef ws
#undef rope
#undef lf
#undef cc
#undef XB
#undef FQB
#undef FKB
#undef FVB
#undef CKVB
#undef QAB
#undef LOB
#undef HB
#undef ssb
}

constexpr int N_PHASES = 12;
#ifndef MK_PER_PHASE
#define MK_PER_PHASE 0
#endif
extern "C" void kernel_launch(void* const* d_in, const int* in_sizes, int n_in, void* d_out, int out_size, void* d_ws, size_t ws_size, hipStream_t stream) {
    static int grid = 0;
    if (grid == 0) {
        if (n_in != 17 || in_sizes[0] != M * D || out_size != M * D || ws_size < WS_END) { fprintf(stderr, "kernel_launch: unexpected shapes (n_in %d, in0 %d, out %d, ws %zu)\n", n_in, n_in > 0 ? in_sizes[0] : -1, out_size, ws_size); grid = -1; return; }
        int dev = 0, cus = 0, per_cu = 0;
        if (hipGetDevice(&dev) != hipSuccess || hipDeviceGetAttribute(&cus, hipDeviceAttributeMultiprocessorCount, dev) != hipSuccess) { grid = -1; return; }
        if (hipFuncSetAttribute((const void*)yoco_fwd, hipFuncAttributeMaxDynamicSharedMemorySize, LDS_BYTES) != hipSuccess) { fprintf(stderr, "kernel_launch: hipFuncSetAttribute failed\n"); grid = -1; return; }
        if (hipOccupancyMaxActiveBlocksPerMultiprocessor(&per_cu, (const void*)yoco_fwd, NWAVES * 64, LDS_BYTES) != hipSuccess || per_cu < 1) { fprintf(stderr, "kernel_launch: occupancy query says %d\n", per_cu); per_cu = 1; }
        (void)hipGetLastError();
        grid = cus * per_cu;
    }
    if (grid < 0) return;
    (void)hipMemsetAsync((char*)d_ws + WS_CTL, 0, CTL_ZERO_BYTES, stream);
    Args a{};
    for (int i = 0; i < 17; ++i) a.in[i] = (const float*)d_in[i];
    a.out = (float*)d_out; a.ws = (unsigned char*)d_ws;
#if MK_PER_PHASE
    for (int p = 0; p < N_PHASES; ++p) { a.ph_lo = p; a.ph_hi = p + 1; hipLaunchKernelGGL(yoco_fwd, dim3(grid), dim3(NWAVES * 64), LDS_BYTES, stream, a); }
#else
    a.ph_lo = 0; a.ph_hi = N_PHASES;
    void* kargs[] = {&a};
    hipError_t e = hipLaunchCooperativeKernel((const void*)yoco_fwd, dim3(grid), dim3(NWAVES * 64), kargs, LDS_BYTES, stream);
    if (e != hipSuccess) fprintf(stderr, "kernel_launch: cooperative launch failed: %s (grid %d)\n", hipGetErrorString(e), grid);
#endif
}
```
